# Optimizing an MI355X kernel written in HIP

```python
import jax
import jax.numpy as jnp
from jax import lax
import numpy as np

D_MODEL = 1024
BATCH = 16
SEQ = 2048
DEPTH = 2

N_GROUPS = 4
HEADS = 4
HEAD_DIM = 64
D_GROUP = HEADS * HEAD_DIM
D_MIX = N_GROUPS * D_GROUP
D_FF = 2816
Q_BLOCK = 128
ROPE_THETA = 10000.0
MLA_Q_RANK = 256
MLA_KV_RANK = 128
MLA_D_NOPE = 64
MLA_D_ROPE = 32
MLA_D_V = 64
NSA_CMP_LEN = 32
NSA_CMP_STRIDE = 16
NSA_SEL_LEN = 64
NSA_N_SEL = 8
NSA_N_INIT = 1
NSA_N_LOCAL = 2
NSA_WINDOW = 512
DSA_TOPK = 256
DSA_IDX_HEADS = 8
DSA_IDX_DIM = 32
DN_ALPHA = (2.0 * DEPTH) ** 0.25
DN_BETA = (8.0 * DEPTH) ** -0.25
LN_EPS = 1e-5
RMS_EPS = 1e-6
NEG_INF = -1e30
FORCE_SCORE = 1e4

IN_SPLITS = (
    ('mla_cq', MLA_Q_RANK), ('mla_ckv', MLA_KV_RANK), ('mla_krope', MLA_D_ROPE),
    ('nsa_q', D_GROUP), ('nsa_k_cmp', HEAD_DIM), ('nsa_v_cmp', HEAD_DIM),
    ('nsa_k_slc', HEAD_DIM), ('nsa_v_slc', HEAD_DIM), ('nsa_k_win', HEAD_DIM),
    ('nsa_v_win', HEAD_DIM), ('nsa_gate', 3 * HEADS),
    ('dsa_q', D_GROUP), ('dsa_k', HEAD_DIM), ('dsa_v', HEAD_DIM),
    ('idx_q', DSA_IDX_HEADS * DSA_IDX_DIM), ('idx_k', DSA_IDX_DIM), ('idx_w', DSA_IDX_HEADS),
    ('sb_q', D_GROUP), ('sb_k', D_GROUP), ('sb_v', D_GROUP),
)
D_IN = sum(w for _, w in IN_SPLITS)

kernel_name = 'hybrid_mla_nsa_dsa_stickbreak_block'


def layer_norm(x, g, b):
    xf = x.astype(jnp.float32)
    mu = jnp.mean(xf, -1, keepdims=True)
    var = jnp.mean(jnp.square(xf - mu), -1, keepdims=True)
    return ((xf - mu) * lax.rsqrt(var + LN_EPS) * g + b).astype(x.dtype)


def rms_norm(x, g):
    xf = x.astype(jnp.float32)
    return (xf * lax.rsqrt(jnp.mean(xf * xf, -1, keepdims=True) + RMS_EPS) * g).astype(x.dtype)


def swiglu(x, w1, w3, w2):
    return (jax.nn.silu(x @ w1) * (x @ w3)) @ w2


def rope_tables(seq, dim):
    inv = ROPE_THETA ** (-jnp.arange(0, dim, 2, dtype=jnp.float32) / dim)
    ang = jnp.arange(seq, dtype=jnp.float32)[:, None] * inv[None, :]
    return jnp.cos(ang), jnp.sin(ang)


def apply_rope(z, cos, sin):
    shape = (cos.shape[0],) + (1,) * (z.ndim - 3) + (cos.shape[1],)
    c = cos.reshape(shape).astype(z.dtype)
    s = sin.reshape(shape).astype(z.dtype)
    z1, z2 = jnp.split(z, 2, axis=-1)
    return jnp.concatenate([z1 * c - z2 * s, z1 * s + z2 * c], axis=-1)


def masked_softmax(s, mask):
    s = jnp.where(mask, s, NEG_INF)
    e = jnp.where(mask, jnp.exp(s - jnp.max(s, -1, keepdims=True)), 0.0)
    return e / jnp.maximum(jnp.sum(e, -1, keepdims=True), 1e-30)


def unblock(y):
    nb, b, qb = y.shape[:3]
    return jnp.moveaxis(y, 0, 1).reshape((b, nb * qb) + y.shape[3:])


def split_columns(h):
    parts = {}
    off = 0
    for name, width in IN_SPLITS:
        parts[name] = h[..., off:off + width]
        off += width
    return parts


def mla_mixer(c_q, c_kv, k_rope, q_norm_g, w_uq, kv_norm_g, w_ukv, cos_r, sin_r):
    B, S, _ = c_q.shape
    q = (rms_norm(c_q, q_norm_g) @ w_uq).reshape(B, S, HEADS, MLA_D_NOPE + MLA_D_ROPE)
    q_nope = q[..., :MLA_D_NOPE]
    q_pe = apply_rope(q[..., MLA_D_NOPE:], cos_r, sin_r)
    kv = (rms_norm(c_kv, kv_norm_g) @ w_ukv).reshape(B, S, HEADS, MLA_D_NOPE + MLA_D_V)
    k_nope = kv[..., :MLA_D_NOPE]
    v = kv[..., MLA_D_NOPE:]
    k_pe = apply_rope(k_rope, cos_r, sin_r)
    scale = (MLA_D_NOPE + MLA_D_ROPE) ** -0.5
    k_pos = jnp.arange(S)

    def block(i):
        q0 = i * Q_BLOCK
        qn = lax.dynamic_slice_in_dim(q_nope, q0, Q_BLOCK, 1)
        qp = lax.dynamic_slice_in_dim(q_pe, q0, Q_BLOCK, 1)
        s = jnp.einsum('bqhd,bkhd->bhqk', qn, k_nope) + jnp.einsum('bqhd,bkd->bhqk', qp, k_pe)
        q_pos = q0 + jnp.arange(Q_BLOCK)
        p = masked_softmax(s.astype(jnp.float32) * scale, k_pos[None, :] <= q_pos[:, None])
        return jnp.einsum('bhqk,bkhd->bqhd', p.astype(v.dtype), v)

    return unblock(lax.map(block, jnp.arange(S // Q_BLOCK))).reshape(B, S, D_GROUP)


def nsa_mixer(q, k_cmp, v_cmp, k_slc, v_slc, k_win, v_win, gate_logits,
              cmp_pos, wk1, wk2, wv1, wv2, cos_h, sin_h):
    B, S, _ = q.shape
    q = apply_rope(q.reshape(B, S, HEADS, HEAD_DIM), cos_h, sin_h)
    k_cmp = apply_rope(k_cmp, cos_h, sin_h)
    k_slc = apply_rope(k_slc, cos_h, sin_h)
    k_win = apply_rope(k_win, cos_h, sin_h)
    scale = HEAD_DIM ** -0.5
    t_pos = jnp.arange(S)

    n_cmp = (S - NSA_CMP_LEN) // NSA_CMP_STRIDE + 1
    tok = np.arange(n_cmp)[:, None] * NSA_CMP_STRIDE + np.arange(NSA_CMP_LEN)[None, :]

    def compress(z, w1, w2):
        blk = (z[:, tok] + cmp_pos).reshape(B, n_cmp, NSA_CMP_LEN * HEAD_DIM)
        return jax.nn.gelu(blk @ w1) @ w2

    kc = compress(k_cmp, wk1, wk2)
    vc = compress(v_cmp, wv1, wv2)
    s_c = jnp.einsum('bshd,bnd->bhsn', q, kc).astype(jnp.float32) * scale
    p_c = masked_softmax(s_c, tok[:, -1][None, :] <= t_pos[:, None])
    o_cmp = jnp.einsum('bhsn,bnd->bshd', p_c.astype(vc.dtype), vc)

    n_slc = S // NSA_SEL_LEN
    slc_start = np.arange(n_slc) * NSA_SEL_LEN
    overlap = ((tok[:, :1] <= slc_start[None, :] + NSA_SEL_LEN - 1)
               & (tok[:, -1:] >= slc_start[None, :])).astype(np.float32)
    imp = jnp.einsum('bhsn,nj->bsj', p_c, jnp.asarray(overlap))
    cur = (t_pos // NSA_SEL_LEN)[:, None]
    jb = jnp.arange(n_slc)[None, :]
    forced = (jb < NSA_N_INIT) | ((jb <= cur) & (jb > cur - NSA_N_LOCAL))
    imp = jnp.where(forced, FORCE_SCORE, jnp.where(jb <= cur, imp, NEG_INF))
    n_top = min(NSA_N_SEL, n_slc)
    _, sel = lax.top_k(imp, n_top)
    k_blk = k_slc.reshape(B, n_slc, NSA_SEL_LEN, HEAD_DIM)
    v_blk = v_slc.reshape(B, n_slc, NSA_SEL_LEN, HEAD_DIM)
    kw = jnp.pad(k_win, ((0, 0), (NSA_WINDOW, 0), (0, 0)))
    vw = jnp.pad(v_win, ((0, 0), (NSA_WINDOW, 0), (0, 0)))
    b_idx = jnp.arange(B)[:, None, None]
    n_sel_tok = n_top * NSA_SEL_LEN

    def block(i):
        q0 = i * Q_BLOCK
        qb = lax.dynamic_slice_in_dim(q, q0, Q_BLOCK, 1)
        q_pos = q0 + jnp.arange(Q_BLOCK)
        idx = lax.dynamic_slice_in_dim(sel, q0, Q_BLOCK, 1)
        kg = k_blk[b_idx, idx].reshape(B, Q_BLOCK, n_sel_tok, HEAD_DIM)
        vg = v_blk[b_idx, idx].reshape(B, Q_BLOCK, n_sel_tok, HEAD_DIM)
        g_pos = (idx[..., None] * NSA_SEL_LEN + jnp.arange(NSA_SEL_LEN)).reshape(B, Q_BLOCK, n_sel_tok)
        s = jnp.einsum('bqhd,bqkd->bhqk', qb, kg).astype(jnp.float32) * scale
        p = masked_softmax(s, (g_pos <= q_pos[None, :, None])[:, None])
        o_s = jnp.einsum('bhqk,bqkd->bqhd', p.astype(vg.dtype), vg)
        kb = lax.dynamic_slice_in_dim(kw, q0, NSA_WINDOW + Q_BLOCK, 1)
        vb = lax.dynamic_slice_in_dim(vw, q0, NSA_WINDOW + Q_BLOCK, 1)
        w_pos = q0 - NSA_WINDOW + jnp.arange(NSA_WINDOW + Q_BLOCK)
        dist = q_pos[:, None] - w_pos[None, :]
        s = jnp.einsum('bqhd,bkd->bhqk', qb, kb).astype(jnp.float32) * scale
        p = masked_softmax(s, (dist >= 0) & (dist < NSA_WINDOW) & (w_pos[None, :] >= 0))
        o_w = jnp.einsum('bhqk,bkd->bqhd', p.astype(vb.dtype), vb)
        return o_s, o_w

    o_slc, o_win = lax.map(block, jnp.arange(S // Q_BLOCK))
    o_slc = unblock(o_slc)
    o_win = unblock(o_win)
    g = jax.nn.sigmoid(gate_logits).reshape(B, S, 3, HEADS)[..., None]
    o = g[:, :, 0] * o_cmp + g[:, :, 1] * o_slc + g[:, :, 2] * o_win
    return o.reshape(B, S, D_GROUP)


def dsa_mixer(q, k, v, q_idx, k_idx, w_idx, cos_h, sin_h, cos_i, sin_i):
    B, S, _ = q.shape
    q = apply_rope(q.reshape(B, S, HEADS, HEAD_DIM), cos_h, sin_h)
    k = apply_rope(k, cos_h, sin_h)
    q_idx = apply_rope(q_idx.reshape(B, S, DSA_IDX_HEADS, DSA_IDX_DIM), cos_i, sin_i)
    k_idx = apply_rope(k_idx, cos_i, sin_i)
    w_idx = w_idx.astype(jnp.float32) * (DSA_IDX_HEADS * DSA_IDX_DIM) ** -0.5
    scale = HEAD_DIM ** -0.5
    n_top = min(DSA_TOPK, S // 4)
    k_pos = jnp.arange(S)
    b_idx = jnp.arange(B)[:, None, None]

    def block(i):
        q0 = i * Q_BLOCK
        q_pos = q0 + jnp.arange(Q_BLOCK)
        qi = lax.dynamic_slice_in_dim(q_idx, q0, Q_BLOCK, 1)
        wi = lax.dynamic_slice_in_dim(w_idx, q0, Q_BLOCK, 1)
        rel = jax.nn.relu(jnp.einsum('bqhd,bsd->bqhs', qi, k_idx).astype(jnp.float32))
        score = jnp.einsum('bqh,bqhs->bqs', wi, rel)
        score = jnp.where(k_pos[None, None, :] <= q_pos[None, :, None], score, NEG_INF)
        _, idx = lax.top_k(score, n_top)
        kg = k[b_idx, idx]
        vg = v[b_idx, idx]
        qb = lax.dynamic_slice_in_dim(q, q0, Q_BLOCK, 1)
        s = jnp.einsum('bqhd,bqkd->bhqk', qb, kg).astype(jnp.float32) * scale
        p = masked_softmax(s, (idx <= q_pos[None, :, None])[:, None])
        return jnp.einsum('bhqk,bqkd->bqhd', p.astype(vg.dtype), vg)

    return unblock(lax.map(block, jnp.arange(S // Q_BLOCK))).reshape(B, S, D_GROUP)


def stick_breaking_mixer(q, k, v):
    B, S, _ = q.shape
    q = q.reshape(B, S, HEADS, HEAD_DIM)
    k = k.reshape(B, S, HEADS, HEAD_DIM)
    v = v.reshape(B, S, HEADS, HEAD_DIM)
    scale = HEAD_DIM ** -0.5
    k_pos = jnp.arange(S)

    def block(i):
        q0 = i * Q_BLOCK
        qb = lax.dynamic_slice_in_dim(q, q0, Q_BLOCK, 1)
        q_pos = q0 + jnp.arange(Q_BLOCK)
        z = jnp.einsum('bqhd,bkhd->bhqk', qb, k).astype(jnp.float32) * scale
        mask = k_pos[None, :] < q_pos[:, None]
        log_1m = jnp.where(mask, jax.nn.log_sigmoid(-z), 0.0)
        after = lax.cumsum(log_1m, axis=3, reverse=True) - log_1m
        a = jnp.where(mask, jnp.exp(jax.nn.log_sigmoid(z) + after), 0.0)
        return jnp.einsum('bhqk,bkhd->bqhd', a.astype(v.dtype), v)

    return unblock(lax.map(block, jnp.arange(S // Q_BLOCK))).reshape(B, S, D_GROUP)


def hybrid_mixer(x, w_in, mla_q_norm, mla_w_uq, mla_kv_norm, mla_w_ukv, nsa_cmp_pos,
                 nsa_cmp_wk1, nsa_cmp_wk2, nsa_cmp_wv1, nsa_cmp_wv2, group_norm_g, w_out,
                 cos_h, sin_h, cos_r, sin_r, cos_i, sin_i):
    B, S, _ = x.shape
    h = split_columns(x @ w_in)
    y_a = mla_mixer(h['mla_cq'], h['mla_ckv'], h['mla_krope'], mla_q_norm, mla_w_uq,
                    mla_kv_norm, mla_w_ukv, cos_r, sin_r)
    y_b = nsa_mixer(h['nsa_q'], h['nsa_k_cmp'], h['nsa_v_cmp'], h['nsa_k_slc'], h['nsa_v_slc'],
                    h['nsa_k_win'], h['nsa_v_win'], h['nsa_gate'], nsa_cmp_pos,
                    nsa_cmp_wk1, nsa_cmp_wk2, nsa_cmp_wv1, nsa_cmp_wv2, cos_h, sin_h)
    y_c = dsa_mixer(h['dsa_q'], h['dsa_k'], h['dsa_v'], h['idx_q'], h['idx_k'], h['idx_w'],
                    cos_h, sin_h, cos_i, sin_i)
    y_d = stick_breaking_mixer(h['sb_q'], h['sb_k'], h['sb_v'])
    y = jnp.concatenate([y_a, y_b, y_c, y_d], axis=-1).reshape(B, S, N_GROUPS, D_GROUP)
    y = rms_norm(y, group_norm_g.reshape(N_GROUPS, D_GROUP)).reshape(B, S, D_MIX)
    return y @ w_out


def setup_inputs(seed: int = 0) -> dict:
    key = jax.random.key(seed)
    keys = jax.random.split(key, 32)
    counter = [0]

    def nrm(shape, scale):
        k = keys[counter[0]]
        counter[0] += 1
        return jax.random.normal(k, shape, jnp.float32) * scale

    def gain(shape):
        return 1.0 + nrm(shape, 0.02)

    L, D = DEPTH, D_MODEL
    return {
        'x': nrm((BATCH, SEQ, D), 1.0),
        'ln1_g': gain((L, D)),
        'ln1_b': nrm((L, D), 0.02),
        'ffn1_w1': nrm((L, D, D_FF), D ** -0.5),
        'ffn1_w3': nrm((L, D, D_FF), D ** -0.5),
        'ffn1_w2': nrm((L, D_FF, D), DN_BETA * D_FF ** -0.5),
        'w_in': nrm((L, D, D_IN), D ** -0.5),
        'mla_q_norm': gain((L, MLA_Q_RANK)),
        'mla_w_uq': nrm((L, MLA_Q_RANK, HEADS * (MLA_D_NOPE + MLA_D_ROPE)), MLA_Q_RANK ** -0.5),
        'mla_kv_norm': gain((L, MLA_KV_RANK)),
        'mla_w_ukv': nrm((L, MLA_KV_RANK, HEADS * (MLA_D_NOPE + MLA_D_V)), MLA_KV_RANK ** -0.5),
        'nsa_cmp_pos': nrm((L, NSA_CMP_LEN, HEAD_DIM), 0.1),
        'nsa_cmp_wk1': nrm((L, NSA_CMP_LEN * HEAD_DIM, HEAD_DIM), (NSA_CMP_LEN * HEAD_DIM) ** -0.5),
        'nsa_cmp_wk2': nrm((L, HEAD_DIM, HEAD_DIM), HEAD_DIM ** -0.5),
        'nsa_cmp_wv1': nrm((L, NSA_CMP_LEN * HEAD_DIM, HEAD_DIM), (NSA_CMP_LEN * HEAD_DIM) ** -0.5),
        'nsa_cmp_wv2': nrm((L, HEAD_DIM, HEAD_DIM), HEAD_DIM ** -0.5),
        'group_norm_g': gain((L, D_MIX)),
        'w_out': nrm((L, D_MIX, D), DN_BETA * D_MIX ** -0.5),
        'ln2_g': gain((L, D)),
        'ln2_b': nrm((L, D), 0.02),
        'ffn2_w1': nrm((L, D, D_FF), D ** -0.5),
        'ffn2_w3': nrm((L, D, D_FF), D ** -0.5),
        'ffn2_w2': nrm((L, D_FF, D), DN_BETA * D_FF ** -0.5),
        'ln3_g': gain((L, D)),
        'ln3_b': nrm((L, D), 0.02),
    }


def reference(x, ln1_g, ln1_b, ffn1_w1, ffn1_w3, ffn1_w2, w_in, mla_q_norm, mla_w_uq,
              mla_kv_norm, mla_w_ukv, nsa_cmp_pos, nsa_cmp_wk1, nsa_cmp_wk2, nsa_cmp_wv1,
              nsa_cmp_wv2, group_norm_g, w_out, ln2_g, ln2_b, ffn2_w1, ffn2_w3, ffn2_w2,
              ln3_g, ln3_b):
    S = x.shape[1]
    cos_h, sin_h = rope_tables(S, HEAD_DIM)
    cos_r, sin_r = rope_tables(S, MLA_D_ROPE)
    cos_i, sin_i = rope_tables(S, DSA_IDX_DIM)
    for l in range(DEPTH):
        x = layer_norm(DN_ALPHA * x + 0.5 * swiglu(x, ffn1_w1[l], ffn1_w3[l], ffn1_w2[l]),
                       ln1_g[l], ln1_b[l])
        y = hybrid_mixer(x, w_in[l], mla_q_norm[l], mla_w_uq[l], mla_kv_norm[l], mla_w_ukv[l],
                         nsa_cmp_pos[l], nsa_cmp_wk1[l], nsa_cmp_wk2[l], nsa_cmp_wv1[l],
                         nsa_cmp_wv2[l], group_norm_g[l], w_out[l],
                         cos_h, sin_h, cos_r, sin_r, cos_i, sin_i)
        x = layer_norm(DN_ALPHA * x + y, ln2_g[l], ln2_b[l])
        x = layer_norm(DN_ALPHA * x + 0.5 * swiglu(x, ffn2_w1[l], ffn2_w3[l], ffn2_w2[l]),
                       ln3_g[l], ln3_b[l])
    return x
```

```cpp
#include <hip/hip_runtime.h>
#include <cstdio>
#include <cstdint>
namespace pg8 {
#define PG8_LAS __attribute__((address_space(3)))
typedef unsigned short bf16_t;
typedef short bf16x8 __attribute__((ext_vector_type(8)));
typedef float f32x4 __attribute__((ext_vector_type(4)));
typedef unsigned u32x4 __attribute__((ext_vector_type(4)));
constexpr int BM = 256, BK = 64, HALF = 128, HTB = HALF * BK * 2  , STAGE_BYTES = 8 * HTB, NXCD = 8, WGM = 8;

__host__ __device__ __forceinline__ int lds_byte(int r, int c) { const int st = (r >> 4) * 2 + (c >> 5), rr = r & 15, cc = c & 31, ob = rr * 64 + cc * 2; return st * 1024 + (ob ^ (((ob >> 9) & 1) << 5)); }
__host__ __device__ __forceinline__ void stage_rc(int b, int& R, int& C) { const int st = b / 1024, sb = b % 1024, swz = sb ^ (((sb >> 9) & 1) << 5); R = (st >> 1) * 16 + swz / 64; C = (st & 1) * 32 + (swz % 64) / 2; }
__host__ __device__ __forceinline__ int perm32(int rho) { const int n = rho >> 4, i = rho & 15; return 8 * (i >> 2) + 4 * n + (i & 3); }

struct Unit { int pm, pn; };
struct Gemm { const bf16_t* A; const bf16_t* Bt; int M, N, K; };

struct StaticOrder {
    int nM, nN, nwg, G, c;
    __host__ __device__ void init(int M, int N, int G_, int c_) { nM = M / BM; nN = N / BM; nwg = nM * nN; G = G_; c = c_; }
    __host__ __device__ bool next(int i, Unit& u) const {
        const long L = (long)i * G + c; if (L >= nwg) return false;
        int wgid = (int)L; { const int q = nwg / NXCD, r = nwg % NXCD, xcd = wgid % NXCD, off = wgid / NXCD; wgid = (xcd < r ? xcd * (q + 1) : r * (q + 1) + (xcd - r) * q) + off; }
        const int nig = WGM * nN, gid = wgid / nig, fm = gid * WGM, gsz = (nM - fm) < WGM ? (nM - fm) : WGM;
        u.pm = fm + ((wgid % nig) % gsz); u.pn = (wgid % nig) / gsz; return true;
    }
    __device__ __forceinline__ void a_ready(const Unit&) const {}
    __device__ __forceinline__ void done(const Unit&) const {}
};

__device__ __forceinline__ unsigned cvt_pk_bf16(float lo, float hi) { unsigned r; asm volatile("v_cvt_pk_bf16_f32 %0, %1, %2" : "=v"(r) : "v"(lo), "v"(hi)); return r; }
typedef float f32x2 __attribute__((ext_vector_type(2)));
typedef float f32x2 __attribute__((ext_vector_type(2)));
struct EpiBf16 {
    static constexpr bool PERM = true, AFTER_DRAIN = false;
    bf16_t* O; int ldc;
    __device__ __forceinline__ void operator()(const f32x4 (&acc)[2][2][4][2], const Unit& u, int wr, int wc, int fr, int fq) const {
        const int row0 = u.pm * BM + wr * 64 + fr, col0 = u.pn * BM + wc * 32 + 8 * fq;
#pragma unroll
        for (int ai = 0; ai < 2; ++ai)
#pragma unroll
            for (int m = 0; m < 4; ++m) { bf16_t* rowp = O + (size_t)(row0 + ai * HALF + m * 16) * ldc + col0;
#pragma unroll
                for (int bj = 0; bj < 2; ++bj) { const f32x4 v0 = acc[ai][bj][m][0], v1 = acc[ai][bj][m][1];
                    u32x4 w; w.x = cvt_pk_bf16(v0[0], v0[1]); w.y = cvt_pk_bf16(v0[2], v0[3]); w.z = cvt_pk_bf16(v1[0], v1[1]); w.w = cvt_pk_bf16(v1[2], v1[3]);
                    *(u32x4*)(rowp + bj * HALF) = w; } }
    }
};
__device__ __forceinline__ float silu_mul(float g, float u) { return g * __builtin_amdgcn_rcpf(1.0f + __builtin_amdgcn_exp2f(-1.4426950408889634f * g)) * u; }
struct EpiSwiGLU {
    static constexpr bool PERM = true, AFTER_DRAIN = false;
    bf16_t* O; int ldc;
    __device__ __forceinline__ void operator()(const f32x4 (&acc)[2][2][4][2], const Unit& u, int wr, int wc, int fr, int fq) const {
        const int row0 = u.pm * BM + wr * 64 + fr, col0 = u.pn * HALF + wc * 32 + 8 * fq;
#pragma unroll
        for (int ai = 0; ai < 2; ++ai)
#pragma unroll
            for (int m = 0; m < 4; ++m) { bf16_t* rowp = O + (size_t)(row0 + ai * HALF + m * 16) * ldc + col0;
                const f32x4 g0 = acc[ai][0][m][0], g1 = acc[ai][0][m][1], u0 = acc[ai][1][m][0], u1 = acc[ai][1][m][1];
                u32x4 w; w.x = cvt_pk_bf16(silu_mul(g0[0], u0[0]), silu_mul(g0[1], u0[1])); w.y = cvt_pk_bf16(silu_mul(g0[2], u0[2]), silu_mul(g0[3], u0[3]));
                w.z = cvt_pk_bf16(silu_mul(g1[0], u1[0]), silu_mul(g1[1], u1[1])); w.w = cvt_pk_bf16(silu_mul(g1[2], u1[2]), silu_mul(g1[3], u1[3]));
                *(u32x4*)rowp = w; }
    }
};
struct EpiResid {
    static constexpr bool PERM = false, AFTER_DRAIN = false;
    const float* xin; float* out; int ldc; float alpha, sc;
    __device__ __forceinline__ void operator()(const f32x4 (&acc)[2][2][4][2], const Unit& u, int wr, int wc, int fr, int fq) const {
        const int row0 = u.pm * BM + wr * 64 + fr, col0 = u.pn * BM + wc * 32 + 4 * fq;
#pragma unroll
        for (int ai = 0; ai < 2; ++ai)
#pragma unroll
            for (int m = 0; m < 4; ++m) { const size_t off = (size_t)(row0 + ai * HALF + m * 16) * ldc + col0;
#pragma unroll
                for (int bj = 0; bj < 2; ++bj)
#pragma unroll
                    for (int n = 0; n < 2; ++n) { const f32x4 xv = *(const f32x4*)(xin + off + bj * HALF + n * 16); *(f32x4*)(out + off + bj * HALF + n * 16) = xv * alpha + acc[ai][bj][m][n] * sc; } }
    }
};
template <class Epi, class Sched, bool ALIGN_EPI = false, bool SP2 = false>
__device__ __forceinline__ void gemm_phase(PG8_LAS unsigned char* lds, const Gemm g, const Sched& S, const Epi& E) {
    int tid_ = threadIdx.x; asm volatile("" : "+v"(tid_));
    const int tid = tid_, wid = __builtin_amdgcn_readfirstlane(tid >> 6), lane = tid & 63, wr = wid >> 2, wc = wid & 3, fr = lane & 15, fq = lane >> 4;
    const int K = g.K, nt = K / BK;
    unsigned voffA[2], voffB[2];
#pragma unroll
    for (int i = 0; i < 2; ++i) { int R, C; stage_rc(tid * 16 + i * 8192, R, C); const int Rb = Epi::PERM ? ((R & ~31) + perm32(R & 31)) : R;
        voffA[i] = (unsigned)(R * K + C) * 2u; voffB[i] = (unsigned)(Rb * K + C) * 2u; }
    const size_t kstep = (size_t)(BK * 2);
    const size_t hstep = (size_t)HALF * K * 2;
    const size_t tstep = 2 * hstep;
    const unsigned ldsw = (unsigned)wid * 1024u;
    const int aoff = lds_byte(wr * 64 + fr, fq * 8), boff = lds_byte(wc * 32 + fr, fq * 8);
#define PG8_SA(b, h) (((b) * 2 + (h)) * HTB)
#define PG8_SB(b, h) ((4 + (b) * 2 + (h)) * HTB)
#define PG8_STAGE(bufoff, gbase, voff) do { _Pragma("unroll") for (int _i = 0; _i < 2; ++_i) \
        __builtin_amdgcn_global_load_lds((const unsigned*)((const char*)(gbase) + (voff)[_i]), (PG8_LAS unsigned*)(lds + (bufoff) + ldsw + _i * 8192), 16, 0, 0); } while (0)
#define PG8_LDA(dst, b, h) do { _Pragma("unroll") for (int m = 0; m < 4; ++m) _Pragma("unroll") for (int k = 0; k < 2; ++k) dst[m][k] = *(const PG8_LAS bf16x8*)(lds + PG8_SA(b, h) + aoff + m * 2048 + k * 1024); } while (0)
#define PG8_LDB(dst, b, h) do { _Pragma("unroll") for (int n = 0; n < 2; ++n) _Pragma("unroll") for (int k = 0; k < 2; ++k) dst[n][k] = *(const PG8_LAS bf16x8*)(lds + PG8_SB(b, h) + boff + n * 2048 + k * 1024); } while (0)
#define PG8_MMA(ai, bj, At, Bt) do { __builtin_amdgcn_s_setprio(1); _Pragma("unroll") for (int m = 0; m < 4; ++m) _Pragma("unroll") for (int n = 0; n < 2; ++n) _Pragma("unroll") for (int k = 0; k < 2; ++k) \
        acc[ai][bj][m][n] = __builtin_amdgcn_mfma_f32_16x16x32_bf16(Bt[n][k], At[m][k], acc[ai][bj][m][n], 0, 0, 0); __builtin_amdgcn_s_setprio(0); } while (0)
#define PG8_WAIT_V(n) asm volatile("s_waitcnt vmcnt(" #n ")" ::: "memory")
#define PG8_WAIT_L(n) asm volatile("s_waitcnt lgkmcnt(" #n ")" ::: "memory")
#define PG8_BAR __builtin_amdgcn_s_barrier()
#define PG8_SCHED __builtin_amdgcn_sched_barrier(0)
    Unit cur, nxt; int ui = 0;
    if (!S.next(0, cur)) return;
    f32x4 acc[2][2][4][2];
#pragma unroll
    for (int a = 0; a < 2; ++a)
#pragma unroll
        for (int b = 0; b < 2; ++b)
#pragma unroll
            for (int m = 0; m < 4; ++m)
#pragma unroll
                for (int n = 0; n < 2; ++n) acc[a][b][m][n] = (f32x4){0.f, 0.f, 0.f, 0.f};
    bf16x8 At[4][2], B0[2][2], B1[2][2];
    const char* cA = (const char*)g.A + (size_t)cur.pm * tstep; const char* cB = (const char*)g.Bt + (size_t)cur.pn * tstep;
    S.a_ready(cur);
    if constexpr (SP2) {
        PG8_STAGE(PG8_SB(0, 0), cB, voffB); PG8_STAGE(PG8_SB(0, 1), cB + hstep, voffB); PG8_STAGE(PG8_SA(0, 0), cA, voffA); PG8_STAGE(PG8_SA(0, 1), cA + hstep, voffA);
        if (wr == 1) PG8_BAR;
        PG8_WAIT_V(2); PG8_BAR;
        PG8_STAGE(PG8_SB(1, 0), cB + kstep, voffB); PG8_STAGE(PG8_SA(1, 0), cA + kstep, voffA); PG8_STAGE(PG8_SB(1, 1), cB + hstep + kstep, voffB);
        PG8_WAIT_V(6); PG8_BAR;
    } else {
        PG8_STAGE(PG8_SB(0, 0), cB, voffB); PG8_STAGE(PG8_SA(0, 0), cA, voffA); PG8_STAGE(PG8_SB(0, 1), cB + hstep, voffB); PG8_STAGE(PG8_SA(0, 1), cA + hstep, voffA);
        if (wr == 1) PG8_BAR;
        PG8_WAIT_V(4); PG8_BAR;
        PG8_STAGE(PG8_SB(1, 0), cB + kstep, voffB); PG8_STAGE(PG8_SA(1, 0), cA + kstep, voffA); PG8_STAGE(PG8_SB(1, 1), cB + hstep + kstep, voffB);
        PG8_WAIT_V(6); PG8_BAR;
    }
    for (;;) {
        const bool has_next = S.next(ui + 1, nxt);
        const char* nA = has_next ? (const char*)g.A + (size_t)nxt.pm * tstep : cA; const char* nB = has_next ? (const char*)g.Bt + (size_t)nxt.pn * tstep : cB;
        for (int t = 0; t < nt; t += 2) {
            const bool last = (t == nt - 2);
            const char* a1 = cA + (size_t)(t + 1) * kstep;
            const char* a2 = last ? nA : cA + (size_t)(t + 2) * kstep; const char* b2 = last ? nB : cB + (size_t)(t + 2) * kstep;
            const char* a3 = a2 + kstep; const char* b3 = b2 + kstep;
            if (last && has_next) S.a_ready(nxt);
            if constexpr (SP2) {
            PG8_LDB(B0, 0, 0); PG8_LDB(B1, 0, 1); PG8_SCHED; PG8_LDA(At, 0, 0); PG8_STAGE(PG8_SA(1, 1), a1 + hstep, voffA);
            PG8_WAIT_V(8); PG8_WAIT_L(0); PG8_BAR; PG8_MMA(0, 0, At, B0); PG8_MMA(0, 1, At, B1); PG8_BAR; PG8_SCHED;
            PG8_LDA(At, 0, 1); PG8_STAGE(PG8_SB(0, 0), b2, voffB); PG8_STAGE(PG8_SB(0, 1), b2 + hstep, voffB); PG8_STAGE(PG8_SA(0, 0), a2, voffA);
            PG8_WAIT_V(8); PG8_WAIT_L(0); PG8_BAR; PG8_MMA(1, 0, At, B0); PG8_MMA(1, 1, At, B1); PG8_BAR; PG8_SCHED;
            PG8_LDB(B0, 1, 0); PG8_LDB(B1, 1, 1); PG8_SCHED; PG8_LDA(At, 1, 0); PG8_STAGE(PG8_SA(0, 1), a2 + hstep, voffA);
            PG8_WAIT_V(8); PG8_WAIT_L(0); PG8_BAR; PG8_MMA(0, 0, At, B0); PG8_MMA(0, 1, At, B1); PG8_BAR; PG8_SCHED;
            PG8_LDA(At, 1, 1); PG8_STAGE(PG8_SB(1, 0), b3, voffB); PG8_STAGE(PG8_SB(1, 1), b3 + hstep, voffB); PG8_STAGE(PG8_SA(1, 0), a3, voffA);
            PG8_WAIT_V(8); PG8_WAIT_L(0); PG8_BAR; PG8_MMA(1, 0, At, B0); PG8_MMA(1, 1, At, B1); PG8_BAR; PG8_SCHED;
            } else {
            PG8_LDB(B0, 0, 0); PG8_SCHED; PG8_LDA(At, 0, 0); PG8_STAGE(PG8_SA(1, 1), a1 + hstep, voffA);
            PG8_WAIT_L(8); PG8_BAR; PG8_WAIT_L(0); PG8_MMA(0, 0, At, B0); PG8_BAR; PG8_SCHED;
            PG8_LDB(B1, 0, 1); PG8_STAGE(PG8_SB(0, 0), b2, voffB);
            PG8_BAR; PG8_WAIT_L(0); PG8_MMA(0, 1, At, B1); PG8_BAR;
            PG8_LDA(At, 0, 1); PG8_STAGE(PG8_SA(0, 0), a2, voffA);
            PG8_BAR; PG8_WAIT_L(0); PG8_MMA(1, 0, At, B0); PG8_BAR; PG8_SCHED;
            PG8_STAGE(PG8_SB(0, 1), b2 + hstep, voffB);
            PG8_WAIT_V(6); PG8_BAR; PG8_MMA(1, 1, At, B1); PG8_BAR;
            PG8_LDB(B0, 1, 0); PG8_SCHED; PG8_LDA(At, 1, 0); PG8_STAGE(PG8_SA(0, 1), a2 + hstep, voffA);
            PG8_WAIT_L(8); PG8_BAR; PG8_WAIT_L(0); PG8_MMA(0, 0, At, B0); PG8_BAR; PG8_SCHED;
            PG8_LDB(B1, 1, 1); PG8_STAGE(PG8_SB(1, 0), b3, voffB);
            PG8_BAR; PG8_WAIT_L(0); PG8_MMA(0, 1, At, B1); PG8_BAR;
            PG8_LDA(At, 1, 1); PG8_STAGE(PG8_SA(1, 0), a3, voffA);
            PG8_BAR; PG8_WAIT_L(0); PG8_MMA(1, 0, At, B0); PG8_BAR; PG8_SCHED;
            PG8_STAGE(PG8_SB(1, 1), b3 + hstep, voffB);
            PG8_WAIT_V(6); PG8_BAR; PG8_MMA(1, 1, At, B1); PG8_BAR;
            }
        }
        if constexpr (ALIGN_EPI) { if (wr == 0) PG8_BAR; }
        if constexpr (!Epi::AFTER_DRAIN) { E(acc, cur, wr, wc, fr, fq); S.done(cur); }
        if (!has_next) break;
#pragma unroll
        for (int a = 0; a < 2; ++a)
#pragma unroll
            for (int b = 0; b < 2; ++b)
#pragma unroll
                for (int m = 0; m < 4; ++m)
#pragma unroll
                    for (int n = 0; n < 2; ++n) acc[a][b][m][n] = (f32x4){0.f, 0.f, 0.f, 0.f};
        cur = nxt; cA = nA; cB = nB; ++ui;
        if constexpr (ALIGN_EPI) { if (wr == 1) PG8_BAR; }
    }
    PG8_WAIT_V(0);
    if constexpr (!ALIGN_EPI) { if (wr == 0) PG8_BAR; }
    PG8_BAR;
    if constexpr (Epi::AFTER_DRAIN) { E.fused(acc, cur, wr, wc, fr, fq, lds, wid, lane); S.done(cur); }
#undef PG8_SA
#undef PG8_SB
#undef PG8_STAGE
#undef PG8_LDA
#undef PG8_LDB
#undef PG8_MMA
#undef PG8_WAIT_V
#undef PG8_WAIT_L
#undef PG8_BAR
#undef PG8_SCHED
}
}
#define GAS __attribute__((address_space(1)))
#define LAS __attribute__((address_space(3)))
typedef unsigned short bf16;
typedef unsigned v4u __attribute__((ext_vector_type(4)));
typedef float f32x4 __attribute__((ext_vector_type(4)));
typedef short bf16x8 __attribute__((ext_vector_type(8)));
typedef GAS unsigned gu32;
typedef GAS unsigned long long gu64;
#define RLX_AGENT __ATOMIC_RELAXED, __HIP_MEMORY_SCOPE_AGENT
#define LDS_WAIT() asm volatile("s_waitcnt lgkmcnt(0)" ::: "memory")
#define VM_WAIT() asm volatile("s_waitcnt vmcnt(0)" ::: "memory")
__device__ __forceinline__ unsigned long long rt() { return __builtin_amdgcn_s_memrealtime(); }
__device__ __forceinline__ unsigned f2bf(float f) { unsigned u = __builtin_bit_cast(unsigned, f); return (u + 0x7fffu + ((u >> 16) & 1u)) >> 16; }
__device__ __forceinline__ unsigned pk2(float lo, float hi) { return f2bf(lo) | (f2bf(hi) << 16); }

#define XB_TMO      128
#define XB_XCNT(j)  (256  + 64 * (j))
#define XB_XSUB(j)  (1280 + 64 * (j))
#define XB_XGEN(j)  (2304 + 64 * (j))
#define XB_TOP      3328
#define XB_TOPGEN   3392
#define XCD_BAR_WORDS 3456
#define XB_SPIN_CAP (1u << 18)

__device__ __forceinline__ unsigned xb_ld(unsigned* p)              { return __hip_atomic_load(p, __ATOMIC_RELAXED, __HIP_MEMORY_SCOPE_AGENT); }
__device__ __forceinline__ unsigned xb_add(unsigned* p, unsigned v) { return __hip_atomic_fetch_add(p, v, __ATOMIC_RELAXED, __HIP_MEMORY_SCOPE_AGENT); }
__device__ __forceinline__ unsigned xb_xcc_id() { return (unsigned)__builtin_amdgcn_s_getreg((3 << 11) | 20) & 0xFu; }
#define XB_SPIN(cond, bar) do { unsigned _sp = 0; while (cond) { __builtin_amdgcn_s_sleep(1); \
    if ((++_sp & 255u) == 0u) { if (xb_ld(&(bar)[XB_TMO])) break; if (_sp > XB_SPIN_CAP) { atomicAdd(&(bar)[XB_TMO], 1u); break; } } } } while (0)

struct XcdBarrier {
    unsigned* bar; unsigned x;
    volatile LAS unsigned* st;
};

__device__ __forceinline__ XcdBarrier xcd_barrier_post(unsigned* bar, volatile LAS unsigned* st) {
    XcdBarrier b; b.bar = bar; b.x = xb_xcc_id(); b.st = st;
    if (threadIdx.x == 0) (void)xb_add(&bar[XB_XCNT(b.x)], 1u);
    return b;
}
__device__ __forceinline__ void xcd_barrier_complete(unsigned* bar, unsigned x, unsigned& nloc, unsigned& nx) {
    const unsigned G = gridDim.x * gridDim.y * gridDim.z;
    unsigned sum, cnt, mine, sp = 0u;
    for (;;) {
        sum = 0u; cnt = 0u; mine = 0u;
#pragma unroll
        for (unsigned j = 0; j < 16; ++j) { const unsigned c = xb_ld(&bar[XB_XCNT(j)]); sum += c; cnt += (c > 0u) ? 1u : 0u; mine = (j == x) ? c : mine; }
        if (sum == G) break;
        __builtin_amdgcn_s_sleep(1);
        if ((++sp & 255u) == 0u) { if (xb_ld(&bar[XB_TMO])) break; if (sp > XB_SPIN_CAP) { atomicAdd(&bar[XB_TMO], 1u); break; } }
    }
    nloc = mine > 0u ? mine : 1u; nx = cnt > 0u ? cnt : 1u;
}

__device__ __forceinline__ void xcd_barrier(const XcdBarrier& b) {
    asm volatile("s_waitcnt vmcnt(0)" ::: "memory");
    __syncthreads();
    if (threadIdx.x == 0) {
        unsigned* bar = b.bar;
        __builtin_amdgcn_s_waitcnt(0);
        unsigned nloc = b.st[0], nx = b.st[1];
        if (nloc == 0u) { xcd_barrier_complete(bar, b.x, nloc, nx); b.st[0] = nloc; b.st[1] = nx; }
        const unsigned old = xb_add(&bar[XB_XSUB(b.x)], 1u);
        const unsigned gen = old / nloc;
        if (old + 1u == (gen + 1u) * nloc) {
            __builtin_amdgcn_fence(__ATOMIC_RELEASE, "agent");
            asm volatile("s_waitcnt vmcnt(0)" ::: "memory");
            const unsigned og = xb_add(&bar[XB_TOP], 1u);
            const unsigned tg = og / nx;
            if (og + 1u == (tg + 1u) * nx) xb_add(&bar[XB_TOPGEN], 1u);
            else XB_SPIN(xb_ld(&bar[XB_TOPGEN]) == tg, bar);
            __builtin_amdgcn_fence(__ATOMIC_ACQUIRE, "agent");
            xb_add(&bar[XB_XGEN(b.x)], 1u);
            asm volatile("s_waitcnt vmcnt(0)" ::: "memory");
        } else {
            XB_SPIN(xb_ld(&bar[XB_XGEN(b.x)]) == gen, bar);
            __builtin_amdgcn_fence(__ATOMIC_ACQUIRE, "agent");
            asm volatile("s_waitcnt vmcnt(0)" ::: "memory");
        }
    }
    __syncthreads();
}
constexpr int NWAVES = 8, NTHR = 512;
constexpr int BATCH = 16, SEQ = 2048, DM = 1024, FF = 2816, M = BATCH * SEQ, DEPTH = 2;
constexpr int NH = 3584;
constexpr int DIN = 2516;
constexpr int HC_CQ = 0, HC_CKV = 256, HC_KROPE = 384, HC_GATE = 416, HC_IDXW = 428, HC_IDXK = 448, HC_QEFF = 512, HC_KVEFF = 896,
              HC_NSAQ = 1408, HC_KCMP = 1664, HC_VCMP = 1728, HC_KSLC = 1792, HC_VSLC = 1856, HC_KWIN = 1920, HC_VWIN = 1984,
              HC_DSAQ = 2048, HC_DSAK = 2304, HC_DSAV = 2368, HC_IDXQ = 2432, HC_SBQ = 2688, HC_SBK = 2944, HC_SBV = 3200;
constexpr int SC_CQ = 0, SC_CKV = 256, SC_KROPE = 384, SC_NSAQ = 416, SC_KCMP = 672, SC_GATE = 1056, SC_DSAQ = 1068, SC_DSAK = 1324,
              SC_IDXQ = 1452, SC_IDXK = 1708, SC_IDXW = 1740, SC_SBQ = 1748;
constexpr float LN_EPS = 1e-5f, RMS_EPS = 1e-6f;
constexpr float DN_ALPHA = 1.4142135623730951f;
constexpr float LOG2E = 1.4426950408889634f;
constexpr float QSC_MLA = 0.10206207261596577f * LOG2E;
constexpr float QSC_64 = 0.125f * LOG2E;
enum { I_X = 0, I_LN1G, I_LN1B, I_F1W1, I_F1W3, I_F1W2, I_WIN, I_QNORM, I_WUQ, I_KVNORM, I_WUKV, I_CMPPOS, I_WK1, I_WK2, I_WV1, I_WV2, I_GNG, I_WOUT,
       I_LN2G, I_LN2B, I_F2W1, I_F2W3, I_F2W2, I_LN3G, I_LN3B, N_IN };
constexpr size_t MiB = 1u << 20;
constexpr size_t WS_CTL = 0, CTL_ZERO_BYTES = 64 * 1024;
constexpr size_t WS_TAB = 1 * MiB;
constexpr size_t WS_T32 = WS_TAB + 512 * 1024, WS_CBIAS = WS_TAB + 768 * 1024;
constexpr size_t WS_KC = 2 * MiB;
constexpr size_t WS_SUMSQ = 3 * MiB;
constexpr size_t WS_BITM = 5 * MiB;
constexpr size_t WS_W = 16 * MiB, W_LAYER = 42 * MiB;
constexpr size_t WO_13A = 0, WO_2A = 11 * MiB, WO_13B = 11 * MiB + 5632 * 1024, WO_2B = 27 * MiB + 512 * 1024, WO_IN = 33 * MiB, WO_OUT = 40 * MiB;
constexpr size_t WS_XB = 104 * MiB;
constexpr size_t WS_YCAT = 168 * MiB;
constexpr size_t WS_BIG = 232 * MiB;
constexpr size_t WS_END = 456 * MiB;
static_assert(WO_2A == (size_t)5632 * 1024 * 2 && WO_13B == WO_2A + (size_t)1024 * 2816 * 2 && WO_2B == WO_13B + WO_2A && WO_IN == WO_2B + (size_t)1024 * 2816 * 2 && WO_OUT == WO_IN + (size_t)NH * 1024 * 2 && W_LAYER == WO_OUT + 2 * MiB, "weights map");
static_assert(WS_W + 2 * W_LAYER <= WS_XB && WS_XB + (size_t)M * DM * 2 == WS_YCAT && WS_YCAT + (size_t)M * DM * 2 == WS_BIG && WS_BIG + (size_t)M * NH * 2 == WS_END, "ws map");
constexpr int CW_BAR = 1024;
constexpr int RING_BYTES = 131072, MISC_OFF = RING_BYTES + 320, LDS_BYTES = 147456;
#undef XB_SPIN_CAP
#define XB_SPIN_CAP (1u << 23)
typedef float f32x16 __attribute__((ext_vector_type(16)));
typedef float f32x2 __attribute__((ext_vector_type(2)));
__device__ __forceinline__ float bf2f(unsigned short u) { return __uint_as_float((unsigned)u << 16); }
__device__ __forceinline__ float bflo(unsigned u) { return __uint_as_float(u << 16); }
__device__ __forceinline__ float bfhi(unsigned u) { return __uint_as_float(u & 0xffff0000u); }
__device__ __forceinline__ float wave_sum(float v) {
#pragma unroll
    for (int o = 1; o < 64; o <<= 1) v += __shfl_xor(v, o);
    return v;
}
__device__ __forceinline__ float wave_max(float v) {
#pragma unroll
    for (int o = 1; o < 64; o <<= 1) v = fmaxf(v, __shfl_xor(v, o));
    return v;
}
__device__ __forceinline__ float wave_min(float v) {
#pragma unroll
    for (int o = 1; o < 64; o <<= 1) v = fminf(v, __shfl_xor(v, o));
    return v;
}
__device__ __forceinline__ float ex2(float x) { return __builtin_amdgcn_exp2f(x); }

template <class F> __device__ __forceinline__ void transpose_item(const F& val, int K, bf16* WT, LAS float* scr, int kb, int nb, int lane) {
    const int k0 = 64 * kb, n0 = 32 * nb;
#pragma unroll 4
    for (int i = 0; i < 32; ++i) { const int kk = 2 * i + (lane >> 5); scr[kk * 33 + (lane & 31)] = val(k0 + kk, n0 + (lane & 31)); }
    LDS_WAIT(); asm volatile("" ::: "memory");
    const int c = lane & 7;
#pragma unroll
    for (int j = 0; j < 4; ++j) { const int n = (lane >> 3) + 8 * j; const LAS float* s = scr + (8 * c) * 33 + n;
        v4u o; o.x = pk2(s[0 * 33], s[1 * 33]); o.y = pk2(s[2 * 33], s[3 * 33]); o.z = pk2(s[4 * 33], s[5 * 33]); o.w = pk2(s[6 * 33], s[7 * 33]);
        *(GAS v4u*)(WT + (size_t)(n0 + n) * K + k0 + 8 * c) = o; }
    LDS_WAIT(); asm volatile("" ::: "memory");
}
struct ValW13 { const float* w1; const float* w3;
    __device__ __forceinline__ float operator()(int k, int n) const { const int col = (n >> 8) * 128 + (n & 127); const uintptr_t d = (n & 128) ? ((uintptr_t)w3 - (uintptr_t)w1) : (uintptr_t)0; return ((const float*)((uintptr_t)w1 + d))[(size_t)k * FF + col]; } };
struct ValPlain { const float* w; int ld;
    __device__ __forceinline__ float operator()(int k, int n) const { return w[(size_t)k * ld + n]; } };
struct ValWout { const float* w; const float* g;
    __device__ __forceinline__ float operator()(int k, int n) const { return w[(size_t)k * DM + n] * g[k]; } };
__device__ __forceinline__ int win_src(int n) {
    if (n < 416) return n;
    if (n < 428) return SC_GATE + (n - 416);
    if (n < 436) return SC_IDXW + (n - 428);
    if (n < 448) return -1;
    if (n < 480) return SC_IDXK + (n - 448);
    if (n < 1408) return -1;
    if (n < 1664) return SC_NSAQ + (n - 1408);
    if (n < 2048) return SC_KCMP + (n - 1664);
    if (n < 2304) return SC_DSAQ + (n - 2048);
    if (n < 2432) return SC_DSAK + (n - 2304);
    if (n < 2688) return SC_IDXQ + (n - 2432);
    if (n < 3456) return SC_SBQ + (n - 2688);
    return -1;
}
struct ValWin { const float* win; const float* qn; const float* wuq; const float* kvn; const float* wukv;
    __device__ __forceinline__ float operator()(int k, int n) const {
        const float* wr = win + (size_t)k * DIN;
        if (n >= HC_QEFF && n < HC_KVEFF) { const int c = n - HC_QEFF; float a = 0.f;
            for (int j = 0; j < 256; ++j) a += wr[SC_CQ + j] * qn[j] * wuq[j * 384 + c];
            return a; }
        if (n >= HC_KVEFF && n < HC_NSAQ) { const int c = n - HC_KVEFF; float a = 0.f;
            for (int j = 0; j < 128; ++j) a += wr[SC_CKV + j] * kvn[j] * wukv[j * 512 + c];
            return a; }
        const int s = win_src(n); return s < 0 ? 0.f : wr[s];
    } };
__device__ __forceinline__ f32x2 rope_cs(int t, int i2  ) {
    double inv = 1.0; const double r = 0.7498942093324559;
    for (int q = 0; q < i2; ++q) inv *= r;
    const float ang = (float)t * (float)inv;
    const double a = (double)ang, n = __builtin_rint(a * 0.15915494309189535);
    const double rr = __builtin_fma(-n, 6.283185307179586, a);
    const float rev = (float)(rr * 0.15915494309189535);
    return (f32x2){__builtin_amdgcn_cosf(rev), __builtin_amdgcn_sinf(rev)};
}
struct P { const float* in[N_IN]; float* out; unsigned char* ws; };
#define OPAQUE_V(x) asm volatile("" : "+v"(x))
#define OPAQUE_S(x) asm volatile("" : "+s"(x))
typedef const __attribute__((address_space(4))) P* PP;
__device__ __forceinline__ PP getp() { PP q = (PP)__builtin_amdgcn_kernarg_segment_ptr(); asm volatile("" : "+s"(q)); return q; }

__device__ __forceinline__ void prologue(PP p, LAS unsigned char* ldsL, int gw, int NGW, int lane, int wave) {
    LAS float* scr = (LAS float*)(ldsL + wave * 16384);
    unsigned char* ws = p->ws;
    constexpr int IT_IN = (DM / 64) * (NH / 32), IT_13 = (DM / 64) * (2 * FF / 32), IT_2 = (FF / 64) * (DM / 32), IT_O = (DM / 64) * (DM / 32);
    constexpr int PER_L = IT_IN + 2 * IT_13 + 2 * IT_2 + IT_O;
    for (int it = gw; it < DEPTH * PER_L; it += NGW) {
        const int l = it / PER_L; int r = it % PER_L;
        unsigned char* wl = ws + WS_W + (size_t)l * W_LAYER;
        if (r < IT_IN) { ValWin v{p->in[I_WIN] + (size_t)l * DM * DIN, p->in[I_QNORM] + l * 256, p->in[I_WUQ] + (size_t)l * 256 * 384, p->in[I_KVNORM] + l * 128, p->in[I_WUKV] + (size_t)l * 128 * 512};
            transpose_item(v, DM, (bf16*)(wl + WO_IN), scr, r % (DM / 64), r / (DM / 64), lane); continue; } r -= IT_IN;
        if (r < IT_13) { ValW13 v{p->in[I_F1W1] + (size_t)l * DM * FF, p->in[I_F1W3] + (size_t)l * DM * FF}; transpose_item(v, DM, (bf16*)(wl + WO_13A), scr, r % (DM / 64), r / (DM / 64), lane); continue; } r -= IT_13;
        if (r < IT_13) { ValW13 v{p->in[I_F2W1] + (size_t)l * DM * FF, p->in[I_F2W3] + (size_t)l * DM * FF}; transpose_item(v, DM, (bf16*)(wl + WO_13B), scr, r % (DM / 64), r / (DM / 64), lane); continue; } r -= IT_13;
        if (r < IT_2) { ValPlain v{p->in[I_F1W2] + (size_t)l * FF * DM, DM}; transpose_item(v, FF, (bf16*)(wl + WO_2A), scr, r % (FF / 64), r / (FF / 64), lane); continue; } r -= IT_2;
        if (r < IT_2) { ValPlain v{p->in[I_F2W2] + (size_t)l * FF * DM, DM}; transpose_item(v, FF, (bf16*)(wl + WO_2B), scr, r % (FF / 64), r / (FF / 64), lane); continue; } r -= IT_2;
        { ValWout v{p->in[I_WOUT] + (size_t)l * DM * DM, p->in[I_GNG] + l * DM}; transpose_item(v, DM, (bf16*)(wl + WO_OUT), scr, r % (DM / 64), r / (DM / 64), lane); }
    }
    { f32x2* T64 = (f32x2*)(ws + WS_TAB); f32x2* T32 = (f32x2*)(ws + WS_T32);
      for (int e = gw * 64 + lane; e < SEQ * 32; e += NGW * 64) T64[e] = rope_cs(e >> 5, e & 31);
      for (int e = gw * 64 + lane; e < SEQ * 16; e += NGW * 64) T32[e] = rope_cs(e >> 4, 2 * (e & 15)); }
    if (gw < 4) { const int l = gw >> 1, kv = gw & 1; const float* pos = p->in[I_CMPPOS] + (size_t)l * 2048; const float* w1 = p->in[kv ? I_WV1 : I_WK1] + (size_t)l * 2048 * 64;
        float a = 0.f; for (int r = 0; r < 2048; ++r) a += pos[r] * w1[r * 64 + lane];
        ((float*)(ws + WS_CBIAS))[gw * 64 + lane] = a; }
    { const f32x4* x4 = (const f32x4*)p->in[I_X]; unsigned long long* o8 = (unsigned long long*)(ws + WS_XB);
      for (size_t e = (size_t)gw * 64 + lane; e < (size_t)M * DM / 4; e += (size_t)NGW * 64) { const f32x4 v = x4[e]; o8[e] = (unsigned long long)pk2(v.x, v.y) | ((unsigned long long)pk2(v.z, v.w) << 32); } }
}

__device__ __forceinline__ void ln_phase(float* io, bf16* xb, const float* g, const float* b, int gw, int NGW, int lane) {
    for (int m = gw; m < M; m += NGW) {
        f32x4* xr = (f32x4*)(io + (size_t)m * DM) + lane;
        f32x4 v[4]; float s = 0.f;
#pragma unroll
        for (int j = 0; j < 4; ++j) { v[j] = xr[64 * j]; s += (v[j].x + v[j].y) + (v[j].z + v[j].w); }
        const float mean = wave_sum(s) * (1.f / DM); float s2 = 0.f;
#pragma unroll
        for (int j = 0; j < 4; ++j) { v[j] = v[j] - mean; s2 += (v[j].x * v[j].x + v[j].y * v[j].y) + (v[j].z * v[j].z + v[j].w * v[j].w); }
        const float rstd = 1.f / sqrtf(wave_sum(s2) * (1.f / DM) + LN_EPS);
        unsigned long long* o8 = (unsigned long long*)(xb + (size_t)m * DM) + lane;
#pragma unroll
        for (int j = 0; j < 4; ++j) { const f32x4 gg = ((const f32x4*)g)[64 * j + lane], bb = ((const f32x4*)b)[64 * j + lane]; const f32x4 o = v[j] * rstd * gg + bb;
            xr[64 * j] = o; o8[64 * j] = (unsigned long long)pk2(o.x, o.y) | ((unsigned long long)pk2(o.z, o.w) << 32); }
    }
}
__device__ __forceinline__ void rope_inplace(bf16* hr, int c0, int nh, int half, const f32x2* trow, float f, int lane) {
    for (int pi = lane; pi < nh * half; pi += 64) { const int hd = pi / half, i = pi % half; bf16* q = hr + c0 + hd * 2 * half + i;
        const float z1 = bf2f(q[0]), z2 = bf2f(q[half]); const f32x2 cs = trow[i];
        q[0] = (bf16)f2bf((z1 * cs.x - z2 * cs.y) * f); q[half] = (bf16)f2bf((z1 * cs.y + z2 * cs.x) * f); }
}
__device__ __forceinline__ void scale_inplace(bf16* hr, int c0, int n, float f, int lane) {
    for (int c = 2 * lane; c < n; c += 128) { unsigned* q = (unsigned*)(hr + c0 + c); const unsigned u = *q; *q = pk2(bflo(u) * f, bfhi(u) * f); }
}
__device__ __forceinline__ void prep_token(bf16* hr, int t, const f32x2* T64, const f32x2* T32, int lane) {
    float sq = 0.f, skv = 0.f;
    { const unsigned long long u = *((const unsigned long long*)(hr + HC_CQ) + lane); const unsigned a = (unsigned)u, b = (unsigned)(u >> 32);
      sq = bflo(a) * bflo(a) + bfhi(a) * bfhi(a) + bflo(b) * bflo(b) + bfhi(b) * bfhi(b);
      const unsigned c = *((const unsigned*)(hr + HC_CKV) + lane); skv = bflo(c) * bflo(c) + bfhi(c) * bfhi(c); }
    const float rq = 1.0f / sqrtf(wave_sum(sq) * (1.f / 256.f) + RMS_EPS), rkv = 1.0f / sqrtf(wave_sum(skv) * (1.f / 128.f) + RMS_EPS);
    const f32x2* t64 = T64 + t * 32; const f32x2* t32 = T32 + t * 16;
    for (int e = lane; e < 256; e += 64) { bf16* q = hr + HC_QEFF + (e >> 6) * 96 + (e & 63); *q = (bf16)f2bf(bf2f(*q) * (rq * QSC_MLA)); }
    for (int hd = 0; hd < 4; ++hd) rope_inplace(hr, HC_QEFF + hd * 96 + 64, 1, 16, t32, rq * QSC_MLA, lane);
    scale_inplace(hr, HC_KVEFF, 512, rkv, lane);
    rope_inplace(hr, HC_KROPE, 1, 16, t32, 1.f, lane);
    rope_inplace(hr, HC_NSAQ, 4, 32, t64, QSC_64, lane);
    rope_inplace(hr, HC_KSLC, 1, 32, t64, 1.f, lane);
    rope_inplace(hr, HC_KWIN, 1, 32, t64, 1.f, lane);
    rope_inplace(hr, HC_DSAQ, 4, 32, t64, QSC_64, lane);
    rope_inplace(hr, HC_DSAK, 1, 32, t64, 1.f, lane);
    rope_inplace(hr, HC_IDXQ, 8, 16, t32, 1.f, lane);
    rope_inplace(hr, HC_IDXK, 1, 16, t32, 1.f, lane);
    if (lane < 12) { bf16* q = hr + HC_GATE + lane; *q = (bf16)f2bf(1.0f / (1.0f + __expf(-bf2f(*q)))); }
    else if (lane < 20) { bf16* q = hr + HC_IDXW + (lane - 12); *q = (bf16)f2bf(bf2f(*q) * 0.0625f); }
    scale_inplace(hr, HC_SBQ, 256, 0.125f, lane);
}
__device__ __forceinline__ void compress_item(PP p, int l, int item, LAS float* zs  , int lane) {
    const int kv = item / (BATCH * 128), rem = item % (BATCH * 128), b = rem / 128, n = rem % 128;
    if (n == 127) { ((bf16*)(p->ws + WS_KC))[((size_t)(kv * BATCH + b) * 128 + 127) * 64 + lane] = 0; return; }
    const bf16* hb = (const bf16*)(p->ws + WS_BIG) + (size_t)b * SEQ * NH + (kv ? HC_VCMP : HC_KCMP);
    const f32x2* T64 = (const f32x2*)(p->ws + WS_TAB);
    for (int i = 0; i < 32; ++i) { const int t = 16 * n + i; const bf16* zr = hb + (size_t)t * NH; float v;
        if (kv) v = bf2f(zr[lane]);
        else { const int fi = lane & 31; const f32x2 cs = T64[t * 32 + fi]; const float z1 = bf2f(zr[fi]), z2 = bf2f(zr[fi + 32]); v = (lane < 32) ? (z1 * cs.x - z2 * cs.y) : (z1 * cs.y + z2 * cs.x); }
        zs[i * 64 + lane] = v; }
    LDS_WAIT(); asm volatile("" ::: "memory");
    const float* w1 = p->in[kv ? I_WV1 : I_WK1] + (size_t)l * 2048 * 64; const float* w2 = p->in[kv ? I_WV2 : I_WK2] + (size_t)l * 64 * 64;
    float a = ((const float*)(p->ws + WS_CBIAS))[(l * 2 + kv) * 64 + lane];
    for (int r = 0; r < 2048; r += 4) { const f32x4 z = *(const LAS f32x4*)(zs + r);
        a += z.x * w1[(r + 0) * 64 + lane]; a += z.y * w1[(r + 1) * 64 + lane]; a += z.z * w1[(r + 2) * 64 + lane]; a += z.w * w1[(r + 3) * 64 + lane]; }
    { const float u = 0.7978845608028654f * (a + 0.044715f * a * a * a); const float th = 1.0f - 2.0f / (__expf(2.0f * u) + 1.0f); a = 0.5f * a * (1.0f + th); }
    float o = 0.f;
    for (int j = 0; j < 64; ++j) o += __shfl(a, j) * w2[j * 64 + lane];
    bf16* kc = (bf16*)(p->ws + WS_KC) + ((size_t)(kv * BATCH + b) * 128 + n) * 64;
    kc[lane] = (bf16)f2bf(o);
    LDS_WAIT(); asm volatile("" ::: "memory");
}
template <int N> __device__ __forceinline__ float dot_row(const LAS float* q, const bf16* k) {
    float s = 0.f;
#pragma unroll 2
    for (int c = 0; c < N; c += 8) { const v4u kv = *(const v4u*)(k + c); const f32x4 q0 = *(const LAS f32x4*)(q + c), q1 = *(const LAS f32x4*)(q + c + 4);
        s += q0.x * bflo(kv.x) + q0.y * bfhi(kv.x) + q0.z * bflo(kv.y) + q0.w * bfhi(kv.y) + q1.x * bflo(kv.z) + q1.y * bfhi(kv.z) + q1.z * bflo(kv.w) + q1.w * bfhi(kv.w); }
    return s;
}
template <int DQ1, int DQ2, class Valid>
__device__ __forceinline__ float attn_naive(const LAS float* qs, const bf16* k1, const bf16* k2, const bf16* v, int ldk, int jlo, int jhi, const Valid& valid, int lane, float& l_out) {
    float m = -INFINITY, l = 0.f, o = 0.f;
    for (int j0 = jlo; j0 <= jhi; j0 += 64) {
        const int key = j0 + lane; const bool ok = valid(key);
        unsigned long long bal = __ballot(ok);
        if (bal == 0ull) continue;
        float s = -INFINITY;
        if (ok) { s = dot_row<DQ1>(qs, k1 + (size_t)key * ldk); if constexpr (DQ2 > 0) s += dot_row<DQ2>(qs + DQ1, k2 + (size_t)key * ldk); }
        const float mn = fmaxf(m, wave_max(s)), al = ex2(m - mn), pr = ok ? ex2(s - mn) : 0.f;
        l = l * al + wave_sum(pr); o *= al; m = mn;
        while (bal) { const int jj = __builtin_ctzll(bal); bal &= bal - 1ull; o += __shfl(pr, jj) * bf2f(v[(size_t)(j0 + jj) * ldk + lane]); }
    }
    l_out = l; return o;
}
__device__ __forceinline__ void put_y(bf16* ycat, float* sumsq, int token, int g, int hd, float val, int lane) {
    ycat[(size_t)token * DM + g * 256 + hd * 64 + lane] = (bf16)f2bf(val);
    const float ss = wave_sum(val * val); if (lane == 0) sumsq[(size_t)token * 16 + g * 4 + hd] = ss;
}
__device__ __forceinline__ unsigned dsa_select(const bf16* hb, const bf16* hr, int t, LAS float* ws_, unsigned* bm, int lane) {
    LAS float* qi = ws_; LAS float* wq = ws_ + 256; LAS float* sc = ws_ + 1024;
    for (int c = lane; c < 256; c += 64) qi[c] = bf2f(hr[HC_IDXQ + c]);
    if (lane < 8) wq[lane] = bf2f(hr[HC_IDXW + lane]);
    LDS_WAIT(); asm volatile("" ::: "memory");
    const int nt = (t >> 6) + 1;
    for (int i = 0; i < nt; ++i) { const int key = 64 * i + lane; const bf16* kr = hb + (size_t)key * NH + HC_IDXK; float acc = 0.f;
#pragma unroll 1
        for (int hh = 0; hh < 8; ++hh) acc += wq[hh] * fmaxf(dot_row<32>(qi + hh * 32, kr), 0.f);
        sc[key] = (key <= t) ? acc : -3.0e38f; }
    LDS_WAIT(); asm volatile("" ::: "memory");
    float v[32];
#pragma unroll
    for (int i = 0; i < 32; ++i) v[i] = (i < nt) ? sc[i * 64 + lane] : -3.0e38f;
    float thr = -3.0e38f; bool tie = false; int need = 0;
    const bool all = (t < 256);
    if (!all) {
#define CNT_GE(x, c) do { c = 0; _Pragma("unroll") for (int i_ = 0; i_ < 32; ++i_) c += __builtin_popcountll(__ballot(v[i_] >= (x))); } while (0)
#define CNT_GT(x, c) do { c = 0; _Pragma("unroll") for (int i_ = 0; i_ < 32; ++i_) c += __builtin_popcountll(__ballot(v[i_] > (x))); } while (0)
        float mx = -3.0e38f, mn = 3.0e38f;
#pragma unroll
        for (int i = 0; i < 32; ++i) { mx = fmaxf(mx, v[i]); mn = fminf(mn, (v[i] > -1.0e38f) ? v[i] : 3.0e38f); }
        float hi = wave_max(mx), lo = wave_min(mn); int c;
        CNT_GE(hi, c);
        if (c >= 256) { thr = hi; tie = (c > 256); }
        else for (;;) { const float mid = 0.5f * (lo + hi);
            if (!(mid > lo && mid < hi)) { thr = lo; tie = true; break; }
            CNT_GE(mid, c);
            if (c == 256) { thr = mid; break; }
            if (c > 256) lo = mid; else hi = mid; }
        if (tie) { CNT_GT(thr, c); need = 256 - c; }
#undef CNT_GE
#undef CNT_GT
    }
    unsigned sel = 0u;
#pragma unroll
    for (int i = 0; i < 32; ++i) {
        unsigned long long mask;
        if (all) mask = __ballot(64 * i + lane <= t);
        else { const unsigned long long gt = __ballot(v[i] > thr), eq = __ballot(v[i] == thr); unsigned long long take = eq;
            if (tie) { const int ce = __builtin_popcountll(eq); if (ce <= need) need -= ce; else { unsigned long long mm = eq; take = 0ull; for (int q = 0; q < need; ++q) { const unsigned long long bb = mm & (~mm + 1ull); take |= bb; mm ^= bb; } need = 0; } }
            mask = gt | take; }
        if (lane < 2) bm[2 * i + lane] = (unsigned)(mask >> (32 * lane));
        sel |= (unsigned)((mask >> lane) & 1ull) << i;
    }
    return sel;
}
__device__ __forceinline__ unsigned nsa_cmp_select(const bf16* hr, const bf16* kcb, const bf16* vcb, int t, LAS float* ws_, int lane) {
    LAS float* qs = ws_; LAS float* ps = ws_ + 384; LAS float* oc = ws_ + 512;
    const int nvis = (t >= 31) ? (((t - 31) >> 4) + 1) : 0;
    float ps0 = 0.f, ps1 = 0.f;
    for (int hd = 0; hd < 4; ++hd) {
        qs[lane] = bf2f(hr[HC_NSAQ + 64 * hd + lane]);
        LDS_WAIT(); asm volatile("" ::: "memory");
        float p0 = 0.f, p1 = 0.f, o = 0.f;
        if (nvis > 0) {
            const float s0 = (lane < nvis) ? dot_row<64>(qs, kcb + lane * 64) : -INFINITY, s1 = (64 + lane < nvis) ? dot_row<64>(qs, kcb + (64 + lane) * 64) : -INFINITY;
            const float mx = wave_max(fmaxf(s0, s1));
            p0 = (lane < nvis) ? ex2(s0 - mx) : 0.f; p1 = (64 + lane < nvis) ? ex2(s1 - mx) : 0.f;
            const float inv = 1.0f / fmaxf(wave_sum(p0 + p1), 1e-30f); p0 *= inv; p1 *= inv;
            for (int n = 0; n < nvis; ++n) { const float pn = (n < 64) ? __shfl(p0, n) : __shfl(p1, n - 64); o += pn * bf2f(vcb[n * 64 + lane]); }
        }
        ps0 += p0; ps1 += p1; oc[hd * 64 + lane] = o;
        LDS_WAIT(); asm volatile("" ::: "memory");
    }
    ps[lane] = ps0; ps[64 + lane] = ps1;
    LDS_WAIT(); asm volatile("" ::: "memory");
    const int cur = t >> 6;
    float val = -3.4e38f;
    if (lane < 32) { float imp = 0.f;
        for (int n = 4 * lane - 1; n <= 4 * lane + 3; ++n) if (n >= 0 && n <= 126) imp += ps[n];
        val = (lane == 0 || lane == cur || lane == cur - 1) ? 1.0e4f : ((lane <= cur) ? imp : -1.0e30f); }
    unsigned selmask = 0u;
    for (int r = 0; r < 8; ++r) { const float mx = wave_max(val); const unsigned long long bal = __ballot(val == mx); const int first = __builtin_ctzll(bal);
        selmask |= 1u << first; if (lane == first) val = -3.4e38f; }
    return selmask;
}
__device__ __forceinline__ void attn_token_naive(PP p, int token, LAS float* ws_, int lane) {
    const int b = token / SEQ, t = token % SEQ;
    const bf16* hb = (const bf16*)(p->ws + WS_BIG) + (size_t)b * SEQ * NH; const bf16* hr = hb + (size_t)t * NH;
    bf16* ycat = (bf16*)(p->ws + WS_YCAT); float* sumsq = (float*)(p->ws + WS_SUMSQ);
    LAS float* qs = ws_;
    for (int hd = 0; hd < 4; ++hd) {
        for (int c = lane; c < 96; c += 64) qs[c] = bf2f(hr[HC_QEFF + 96 * hd + c]);
        LDS_WAIT(); asm volatile("" ::: "memory");
        float l; const float o = attn_naive<64, 32>(qs, hb + HC_KVEFF + 128 * hd, hb + HC_KROPE, hb + HC_KVEFF + 128 * hd + 64, NH, 0, t & ~63, [t](int key) { return key <= t; }, lane, l);
        put_y(ycat, sumsq, token, 0, hd, o / fmaxf(l, 1e-30f), lane);
        LDS_WAIT(); asm volatile("" ::: "memory");
    }
    for (int hd = 0; hd < 4; ++hd) {
        qs[lane] = bf2f(hr[HC_SBQ + 64 * hd + lane]);
        LDS_WAIT(); asm volatile("" ::: "memory");
        float o = 0.f, carry = 0.f;
        if (t > 0) for (int j0 = (t - 1) & ~63; j0 >= 0; j0 -= 64) {
            const int key = j0 + lane; const bool ok = key < t;
            const float z = ok ? dot_row<64>(qs, hb + (size_t)key * NH + HC_SBK + 64 * hd) : 0.f;
            const float lm = ok ? -(fmaxf(z, 0.f) + __logf(1.0f + __expf(-fabsf(z)))) : 0.f;
            float incl = lm;
#pragma unroll
            for (int off = 1; off < 64; off <<= 1) { const float u = __shfl_down(incl, off); if (lane + off < 64) incl += u; }
            const float a = ok ? __expf(z + incl + carry) : 0.f;
            carry += __shfl(incl, 0);
            unsigned long long bal = __ballot(ok);
            while (bal) { const int jj = __builtin_ctzll(bal); bal &= bal - 1ull; o += __shfl(a, jj) * bf2f(hb[(size_t)(j0 + jj) * NH + HC_SBV + 64 * hd + lane]); }
            if (carry < -104.f) break;
        }
        put_y(ycat, sumsq, token, 3, hd, o, lane);
        LDS_WAIT(); asm volatile("" ::: "memory");
    }
    {
        const bf16* kcb = (const bf16*)(p->ws + WS_KC) + (size_t)b * 128 * 64; const bf16* vcb = kcb + (size_t)BATCH * 128 * 64;
        const unsigned selmask = nsa_cmp_select(hr, kcb, vcb, t, ws_, lane);
        LAS float* oc = ws_ + 512;
        for (int hd = 0; hd < 4; ++hd) {
            qs[lane] = bf2f(hr[HC_NSAQ + 64 * hd + lane]);
            LDS_WAIT(); asm volatile("" ::: "memory");
            float ls, lw;
            const float os = attn_naive<64, 0>(qs, hb + HC_KSLC, nullptr, hb + HC_VSLC, NH, 0, t & ~63, [t, selmask](int key) { return key <= t && ((selmask >> (key >> 6)) & 1u); }, lane, ls);
            const int klo = t - 511;
            const float ow = attn_naive<64, 0>(qs, hb + HC_KWIN, nullptr, hb + HC_VWIN, NH, (klo > 0 ? klo : 0) & ~63, t & ~63, [t, klo](int key) { return key <= t && key >= klo; }, lane, lw);
            const float g0 = bf2f(hr[HC_GATE + hd]), g1 = bf2f(hr[HC_GATE + 4 + hd]), g2 = bf2f(hr[HC_GATE + 8 + hd]);
            put_y(ycat, sumsq, token, 1, hd, g0 * oc[hd * 64 + lane] + g1 * os / fmaxf(ls, 1e-30f) + g2 * ow / fmaxf(lw, 1e-30f), lane);
            LDS_WAIT(); asm volatile("" ::: "memory");
        }
    }
    {
        const unsigned sel = dsa_select(hb, hr, t, ws_, (unsigned*)(p->ws + WS_BITM) + (size_t)token * 64, lane);
        for (int hd = 0; hd < 4; ++hd) {
            qs[lane] = bf2f(hr[HC_DSAQ + 64 * hd + lane]);
            LDS_WAIT(); asm volatile("" ::: "memory");
            float l; const float o = attn_naive<64, 0>(qs, hb + HC_DSAK, nullptr, hb + HC_DSAV, NH, 0, t & ~63, [sel](int key) { return ((sel >> (key >> 6)) & 1u) != 0u; }, lane, l);
            put_y(ycat, sumsq, token, 2, hd, o / fmaxf(l, 1e-30f), lane);
            LDS_WAIT(); asm volatile("" ::: "memory");
        }
    }
}
__device__ __forceinline__ void gnorm_token(bf16* yr, const float* ss, int lane) {
#pragma unroll
    for (int g = 0; g < 4; ++g) { const float rs = 1.0f / sqrtf((ss[4 * g] + ss[4 * g + 1] + ss[4 * g + 2] + ss[4 * g + 3]) * (1.f / 256.f) + RMS_EPS);
        unsigned long long* q = (unsigned long long*)(yr + g * 256) + lane; const unsigned long long u = *q; const unsigned a = (unsigned)u, b = (unsigned)(u >> 32);
        *q = (unsigned long long)pk2(bflo(a) * rs, bfhi(a) * rs) | ((unsigned long long)pk2(bflo(b) * rs, bfhi(b) * rs) << 32); }
}
__global__ void __launch_bounds__(NTHR, 2) fwd(P p_arg_unused) {
    extern __shared__ __attribute__((aligned(16))) unsigned char lds[];
    LAS unsigned char* ldsL = (LAS unsigned char*)lds;
    const int tid = threadIdx.x, lane0 = tid & 63, wave = __builtin_amdgcn_readfirstlane(tid >> 6);
    const int G = gridDim.x, bx = blockIdx.x, vcu = (G % 8 == 0) ? (bx % 8) * (G / 8) + bx / 8 : bx;
    const int gw0 = vcu * NWAVES + wave, NGW = G * NWAVES;
#define FRESH() int lane = lane0, gw = gw0; OPAQUE_V(lane); OPAQUE_S(gw)
    for (int u = tid; u < (LDS_BYTES - RING_BYTES) / 4; u += NTHR) ((LAS unsigned*)(ldsL + RING_BYTES))[u] = 0u;
    __syncthreads();
    unsigned char* ws = getp()->ws;
    XcdBarrier bar = xcd_barrier_post((unsigned*)(ws + WS_CTL) + CW_BAR, (volatile LAS unsigned*)(ldsL + MISC_OFF) + 8);
    LAS float* wscr = (LAS float*)(ldsL + wave * 16384);
    bf16* XB = (bf16*)(ws + WS_XB); bf16* HB = (bf16*)(ws + WS_BIG); bf16* YC = (bf16*)(ws + WS_YCAT); float* out = getp()->out;

    { FRESH(); prologue(getp(), ldsL, gw, NGW, lane, wave); }
    xcd_barrier(bar);

#define GEMM_PHASE(EPI, A_, B_, N_, K_, ...) do { pg8::Gemm g_{(const pg8::bf16_t*)(A_), (const pg8::bf16_t*)(B_), M, (N_), (K_)}; pg8::StaticOrder S_; S_.init(M, (N_), G, bx); \
        pg8::EPI E_{__VA_ARGS__}; pg8::gemm_phase<pg8::EPI, pg8::StaticOrder, true, true>(ldsL, g_, S_, E_); } while (0)

    for (int l = 0; l < DEPTH; ++l) {
        unsigned char* wl = ws + WS_W + (size_t)l * W_LAYER;
        const float* xin = (l == 0) ? getp()->in[I_X] : out;
        GEMM_PHASE(EpiSwiGLU, XB, wl + WO_13A, 2 * FF, DM, HB, FF);
        xcd_barrier(bar);
        GEMM_PHASE(EpiResid, HB, wl + WO_2A, DM, FF, xin, out, DM, DN_ALPHA, 0.5f);
        xcd_barrier(bar);
        { FRESH(); ln_phase(out, XB, getp()->in[I_LN1G] + l * DM, getp()->in[I_LN1B] + l * DM, gw, NGW, lane); }
        xcd_barrier(bar);
        GEMM_PHASE(EpiBf16, XB, wl + WO_IN, NH, DM, HB, NH);
        xcd_barrier(bar);
        { FRESH(); const f32x2* T64 = (const f32x2*)(ws + WS_TAB); const f32x2* T32 = (const f32x2*)(ws + WS_T32);
          for (int m = gw; m < M; m += NGW) prep_token(HB + (size_t)m * NH, m % SEQ, T64, T32, lane);
          for (int it = gw; it < 2 * BATCH * 128; it += NGW) compress_item(getp(), l, it, wscr, lane); }
        xcd_barrier(bar);
        { FRESH(); for (int it = gw; it < M; it += NGW) attn_token_naive(getp(), (it % BATCH) * SEQ + it / BATCH, wscr, lane); }
        xcd_barrier(bar);
        { FRESH(); for (int m = gw; m < M; m += NGW) gnorm_token(YC + (size_t)m * DM, (const float*)(ws + WS_SUMSQ) + (size_t)m * 16, lane); }
        xcd_barrier(bar);
        GEMM_PHASE(EpiResid, YC, wl + WO_OUT, DM, DM, out, out, DM, DN_ALPHA, 1.0f);
        xcd_barrier(bar);
        { FRESH(); ln_phase(out, XB, getp()->in[I_LN2G] + l * DM, getp()->in[I_LN2B] + l * DM, gw, NGW, lane); }
        xcd_barrier(bar);
        GEMM_PHASE(EpiSwiGLU, XB, wl + WO_13B, 2 * FF, DM, HB, FF);
        xcd_barrier(bar);
        GEMM_PHASE(EpiResid, HB, wl + WO_2B, DM, FF, out, out, DM, DN_ALPHA, 0.5f);
        xcd_barrier(bar);
        { FRESH(); ln_phase(out, XB, getp()->in[I_LN3G] + l * DM, getp()->in[I_LN3B] + l * DM, gw, NGW, lane); }
        xcd_barrier(bar);
    }
#undef GEMM_PHASE
}

extern "C" void kernel_launch(void* const* d_in, const int* in_sizes, int n_in, void* d_out, int out_size, void* d_ws, size_t ws_size, hipStream_t stream) {
    static int grid = 0;
    if (grid == 0) {
        if (n_in != N_IN || in_sizes[0] != M * DM || out_size != M * DM || ws_size < WS_END) { fprintf(stderr, "kernel_launch: unexpected shapes (n_in %d, in0 %d, out %d, ws %zu < %zu); nothing launched\n", n_in, n_in > 0 ? in_sizes[0] : -1, out_size, ws_size, (size_t)WS_END); grid = -1; return; }
        int dev = 0, cus = 0, per_cu = 0;
        if (hipGetDevice(&dev) != hipSuccess || hipDeviceGetAttribute(&cus, hipDeviceAttributeMultiprocessorCount, dev) != hipSuccess) { grid = -1; return; }
        if (hipFuncSetAttribute((const void*)fwd, hipFuncAttributeMaxDynamicSharedMemorySize, LDS_BYTES) != hipSuccess) { fprintf(stderr, "kernel_launch: hipFuncSetAttribute failed\n"); grid = -1; return; }
        if (hipOccupancyMaxActiveBlocksPerMultiprocessor(&per_cu, (const void*)fwd, NTHR, LDS_BYTES) != hipSuccess || per_cu < 1) fprintf(stderr, "kernel_launch: note: occupancy query reports %d\n", per_cu);
        (void)hipGetLastError();
        grid = cus;
    }
    if (grid < 0) return;
    if (hipMemsetAsync((char*)d_ws + WS_CTL, 0, CTL_ZERO_BYTES, stream) != hipSuccess) return;
    P p{};
    for (int i = 0; i < N_IN; ++i) p.in[i] = (const float*)d_in[i];
    p.out = (float*)d_out; p.ws = (unsigned char*)d_ws;
    hipLaunchKernelGGL(fwd, dim3(grid), dim3(NTHR), LDS_BYTES, stream, p);
}
```

```cpp
#include <hip/hip_runtime.h>
#include <cstdio>
#include <cstdint>
namespace pg8 {
#define PG8_LAS __attribute__((address_space(3)))
typedef unsigned short bf16_t;
typedef short bf16x8 __attribute__((ext_vector_type(8)));
typedef float f32x4 __attribute__((ext_vector_type(4)));
typedef unsigned u32x4 __attribute__((ext_vector_type(4)));
typedef int i32x4 __attribute__((ext_vector_type(4)));
constexpr int BM = 256, BK = 64, HALF = 128, HTB = HALF * BK * 2  , STAGE_BYTES = 8 * HTB, NXCD = 8, WGM = 8;

__host__ __device__ __forceinline__ int lds_byte(int r, int c) { const int st = (r >> 4) * 2 + (c >> 5), rr = r & 15, cc = c & 31, ob = rr * 64 + cc * 2; return st * 1024 + (ob ^ (((ob >> 9) & 1) << 5)); }
__host__ __device__ __forceinline__ void stage_rc(int b, int& R, int& C) { const int st = b / 1024, sb = b % 1024, swz = sb ^ (((sb >> 9) & 1) << 5); R = (st >> 1) * 16 + swz / 64; C = (st & 1) * 32 + (swz % 64) / 2; }
__host__ __device__ __forceinline__ int perm32(int rho) { const int n = rho >> 4, i = rho & 15; return 8 * (i >> 2) + 4 * n + (i & 3); }

struct Unit { int pm, pn; };
struct Gemm { const bf16_t* A; const bf16_t* Bt; int M, N, K; };

struct StaticOrder {
    int nM, nN, nwg, G, c;
    __host__ __device__ void init(int M, int N, int G_, int c_) { nM = M / BM; nN = N / BM; nwg = nM * nN; G = G_; c = c_; }
    __host__ __device__ bool next(int i, Unit& u) const {
        const long L = (long)i * G + c; if (L >= nwg) return false;
        int wgid = (int)L; { const int q = nwg / NXCD, r = nwg % NXCD, xcd = wgid % NXCD, off = wgid / NXCD; wgid = (xcd < r ? xcd * (q + 1) : r * (q + 1) + (xcd - r) * q) + off; }
        const int nig = WGM * nN, gid = wgid / nig, fm = gid * WGM, gsz = (nM - fm) < WGM ? (nM - fm) : WGM;
        u.pm = fm + ((wgid % nig) % gsz); u.pn = (wgid % nig) / gsz; return true;
    }
    __device__ __forceinline__ void a_ready(const Unit&) const {}
    __device__ __forceinline__ void done(const Unit&) const {}
};

__device__ __forceinline__ unsigned cvt_pk_bf16(float lo, float hi) { unsigned r; asm volatile("v_cvt_pk_bf16_f32 %0, %1, %2" : "=v"(r) : "v"(lo), "v"(hi)); return r; }
typedef float f32x2 __attribute__((ext_vector_type(2)));
typedef float f32x2 __attribute__((ext_vector_type(2)));
struct EpiBf16 {
    static constexpr bool PERM = true, AFTER_DRAIN = false;
    bf16_t* O; int ldc;
    __device__ __forceinline__ void operator()(const f32x4 (&acc)[2][2][4][2], const Unit& u, int wr, int wc, int fr, int fq) const {
        const int row0 = u.pm * BM + wr * 64 + fr, col0 = u.pn * BM + wc * 32 + 8 * fq;
#pragma unroll
        for (int ai = 0; ai < 2; ++ai)
#pragma unroll
            for (int m = 0; m < 4; ++m) { bf16_t* rowp = O + (size_t)(row0 + ai * HALF + m * 16) * ldc + col0;
#pragma unroll
                for (int bj = 0; bj < 2; ++bj) { const f32x4 v0 = acc[ai][bj][m][0], v1 = acc[ai][bj][m][1];
                    u32x4 w; w.x = cvt_pk_bf16(v0[0], v0[1]); w.y = cvt_pk_bf16(v0[2], v0[3]); w.z = cvt_pk_bf16(v1[0], v1[1]); w.w = cvt_pk_bf16(v1[2], v1[3]);
                    *(u32x4*)(rowp + bj * HALF) = w; } }
    }
};
__device__ __forceinline__ float silu_mul(float g, float u) { return g * __builtin_amdgcn_rcpf(1.0f + __builtin_amdgcn_exp2f(-1.4426950408889634f * g)) * u; }
struct EpiSwiGLU {
    static constexpr bool PERM = true, AFTER_DRAIN = false;
    bf16_t* O; int ldc;
    __device__ __forceinline__ void operator()(const f32x4 (&acc)[2][2][4][2], const Unit& u, int wr, int wc, int fr, int fq) const {
        const int row0 = u.pm * BM + wr * 64 + fr, col0 = u.pn * HALF + wc * 32 + 8 * fq;
#pragma unroll
        for (int ai = 0; ai < 2; ++ai)
#pragma unroll
            for (int m = 0; m < 4; ++m) { bf16_t* rowp = O + (size_t)(row0 + ai * HALF + m * 16) * ldc + col0;
                const f32x4 g0 = acc[ai][0][m][0], g1 = acc[ai][0][m][1], u0 = acc[ai][1][m][0], u1 = acc[ai][1][m][1];
                u32x4 w; w.x = cvt_pk_bf16(silu_mul(g0[0], u0[0]), silu_mul(g0[1], u0[1])); w.y = cvt_pk_bf16(silu_mul(g0[2], u0[2]), silu_mul(g0[3], u0[3]));
                w.z = cvt_pk_bf16(silu_mul(g1[0], u1[0]), silu_mul(g1[1], u1[1])); w.w = cvt_pk_bf16(silu_mul(g1[2], u1[2]), silu_mul(g1[3], u1[3]));
                *(u32x4*)rowp = w; }
    }
};
struct EpiResid {
    static constexpr bool PERM = true, AFTER_DRAIN = false;
    bf16_t* X; int ldc; float alpha, sc;
    __device__ __forceinline__ void operator()(const f32x4 (&acc)[2][2][4][2], const Unit& u, int wr, int wc, int fr, int fq) const {
        const int row0 = u.pm * BM + wr * 64 + fr, col0 = u.pn * BM + wc * 32 + 8 * fq;
#pragma unroll
        for (int ai = 0; ai < 2; ++ai)
#pragma unroll
            for (int m = 0; m < 4; ++m) { bf16_t* rowp = X + (size_t)(row0 + ai * HALF + m * 16) * ldc + col0;
                u32x4 xv[2];
#pragma unroll
                for (int bj = 0; bj < 2; ++bj) xv[bj] = *(const u32x4*)(rowp + bj * HALF);
#pragma unroll
                for (int bj = 0; bj < 2; ++bj) { const f32x4 v0 = acc[ai][bj][m][0], v1 = acc[ai][bj][m][1]; const u32x4 x = xv[bj]; u32x4 w;
                    w.x = cvt_pk_bf16(alpha * __uint_as_float(x.x << 16) + sc * v0[0], alpha * __uint_as_float(x.x & 0xffff0000u) + sc * v0[1]);
                    w.y = cvt_pk_bf16(alpha * __uint_as_float(x.y << 16) + sc * v0[2], alpha * __uint_as_float(x.y & 0xffff0000u) + sc * v0[3]);
                    w.z = cvt_pk_bf16(alpha * __uint_as_float(x.z << 16) + sc * v1[0], alpha * __uint_as_float(x.z & 0xffff0000u) + sc * v1[1]);
                    w.w = cvt_pk_bf16(alpha * __uint_as_float(x.w << 16) + sc * v1[2], alpha * __uint_as_float(x.w & 0xffff0000u) + sc * v1[3]);
                    *(u32x4*)(rowp + bj * HALF) = w; } }
    }
};
struct EpiSwiGLU8 {
    static constexpr bool PERM = true, AFTER_DRAIN = false;
    unsigned char* O; int ldc; float ws;
    __device__ __forceinline__ float sm(float g, float u) const { const float gs = g * ws; return gs * __builtin_amdgcn_rcpf(1.0f + __builtin_amdgcn_exp2f(-1.4426950408889634f * gs)) * (u * ws); }
    __device__ __forceinline__ void operator()(const f32x4 (&acc)[2][2][4][2], const Unit& u, int wr, int wc, int fr, int fq) const {
        const int row0 = u.pm * BM + wr * 64 + fr, col0 = u.pn * HALF + wc * 32 + 8 * fq;
#pragma unroll
        for (int ai = 0; ai < 2; ++ai)
#pragma unroll
            for (int m = 0; m < 4; ++m) { unsigned char* rowp = O + (size_t)(row0 + ai * HALF + m * 16) * ldc + col0;
                int lo = __builtin_amdgcn_cvt_pk_fp8_f32(sm(acc[ai][0][m][0][0], acc[ai][1][m][0][0]), sm(acc[ai][0][m][0][1], acc[ai][1][m][0][1]), 0, false);
                lo = __builtin_amdgcn_cvt_pk_fp8_f32(sm(acc[ai][0][m][0][2], acc[ai][1][m][0][2]), sm(acc[ai][0][m][0][3], acc[ai][1][m][0][3]), lo, true);
                int hi = __builtin_amdgcn_cvt_pk_fp8_f32(sm(acc[ai][0][m][1][0], acc[ai][1][m][1][0]), sm(acc[ai][0][m][1][1], acc[ai][1][m][1][1]), 0, false);
                hi = __builtin_amdgcn_cvt_pk_fp8_f32(sm(acc[ai][0][m][1][2], acc[ai][1][m][1][2]), sm(acc[ai][0][m][1][3], acc[ai][1][m][1][3]), hi, true);
                *(unsigned long long*)rowp = (unsigned long long)(unsigned)lo | ((unsigned long long)(unsigned)hi << 32);
                asm volatile("" ::: "memory"); }
    }
};
template <class Epi, class Sched, bool ALIGN_EPI = false, bool SP2 = false, bool FP8 = false>
__device__ __forceinline__ void gemm_phase(PG8_LAS unsigned char* lds, const Gemm g, const Sched& S, const Epi& E, int tid_in) {
    int tid_ = tid_in; asm volatile("" : "+v"(tid_));
    const int tid = tid_, wid = __builtin_amdgcn_readfirstlane(tid >> 6), lane = tid & 63, wr = wid >> 2, wc = wid & 3, fr = lane & 15, fq = lane >> 4;
    const int K = g.K, nt = K / BK;
    unsigned voffA[2], voffB[2];
#pragma unroll
    for (int i = 0; i < 2; ++i) { int R, C; stage_rc(tid * 16 + i * 8192, R, C); const int Rb = Epi::PERM ? ((R & ~31) + perm32(R & 31)) : R;
        voffA[i] = (unsigned)(R * K + C) * 2u; voffB[i] = (unsigned)(Rb * K + C) * 2u; }
    const size_t kstep = (size_t)(BK * 2);
    const size_t hstep = (size_t)HALF * K * 2;
    const size_t tstep = 2 * hstep;
    const unsigned ldsw = (unsigned)wid * 1024u;
    const int aoff = lds_byte(wr * 64 + fr, fq * 8), boff = lds_byte(wc * 32 + fr, fq * 8);
#define PG8_SA(b, h) (((b) * 2 + (h)) * HTB)
#define PG8_SB(b, h) ((4 + (b) * 2 + (h)) * HTB)
#define PG8_STAGE(bufoff, gbase, voff) do { _Pragma("unroll") for (int _i = 0; _i < 2; ++_i) { \
        if constexpr (FP8) { unsigned keep_;   \
            asm volatile("s_mov_b32 %0, m0\n\ts_mov_b32 m0, %3\n\ts_nop 0\n\tglobal_load_lds_dwordx4 %1, %2\n\ts_mov_b32 m0, %0" : "=&s"(keep_) : "v"((voff)[_i]), "s"((const char*)(gbase)), "s"((unsigned)(uintptr_t)(lds + (bufoff) + ldsw + _i * 8192)) : "memory"); } \
        else __builtin_amdgcn_global_load_lds((const unsigned*)((const char*)(gbase) + (voff)[_i]), (PG8_LAS unsigned*)(lds + (bufoff) + ldsw + _i * 8192), 16, 0, 0); } } while (0)
#define PG8_LDA(dst, b, h) do { _Pragma("unroll") for (int m = 0; m < 4; ++m) _Pragma("unroll") for (int k = 0; k < 2; ++k) dst[m][k] = *(const PG8_LAS bf16x8*)(lds + PG8_SA(b, h) + aoff + m * 2048 + k * 1024); } while (0)
#define PG8_LDB(dst, b, h) do { _Pragma("unroll") for (int n = 0; n < 2; ++n) _Pragma("unroll") for (int k = 0; k < 2; ++k) dst[n][k] = *(const PG8_LAS bf16x8*)(lds + PG8_SB(b, h) + boff + n * 2048 + k * 1024); } while (0)
#define PG8_MMA(ai, bj, At, Bt) do { __builtin_amdgcn_s_setprio(1); \
        if constexpr (FP8) { _Pragma("unroll") for (int m = 0; m < 4; ++m) _Pragma("unroll") for (int n = 0; n < 2; ++n) \
            acc[ai][bj][m][n] = __builtin_amdgcn_mfma_scale_f32_16x16x128_f8f6f4(__builtin_shufflevector(__builtin_bit_cast(i32x4, Bt[n][0]), __builtin_bit_cast(i32x4, Bt[n][1]), 0, 1, 2, 3, 4, 5, 6, 7), \
                __builtin_shufflevector(__builtin_bit_cast(i32x4, At[m][0]), __builtin_bit_cast(i32x4, At[m][1]), 0, 1, 2, 3, 4, 5, 6, 7), acc[ai][bj][m][n], 0, 0, 0, 0x7f7f7f7f, 0, 0x7f7f7f7f); } \
        else { _Pragma("unroll") for (int m = 0; m < 4; ++m) _Pragma("unroll") for (int n = 0; n < 2; ++n) _Pragma("unroll") for (int k = 0; k < 2; ++k) \
            acc[ai][bj][m][n] = __builtin_amdgcn_mfma_f32_16x16x32_bf16(Bt[n][k], At[m][k], acc[ai][bj][m][n], 0, 0, 0); } \
        __builtin_amdgcn_s_setprio(0); } while (0)
#define PG8_WAIT_V(n) asm volatile("s_waitcnt vmcnt(" #n ")" ::: "memory")
#define PG8_WAIT_L(n) asm volatile("s_waitcnt lgkmcnt(" #n ")" ::: "memory")
#define PG8_BAR __builtin_amdgcn_s_barrier()
#define PG8_SCHED __builtin_amdgcn_sched_barrier(0)
    Unit cur, nxt; int ui = 0;
    if (!S.next(0, cur)) return;
    f32x4 acc[2][2][4][2];
#pragma unroll
    for (int a = 0; a < 2; ++a)
#pragma unroll
        for (int b = 0; b < 2; ++b)
#pragma unroll
            for (int m = 0; m < 4; ++m)
#pragma unroll
                for (int n = 0; n < 2; ++n) acc[a][b][m][n] = (f32x4){0.f, 0.f, 0.f, 0.f};
    bf16x8 At[4][2], B0[2][2], B1[2][2];
    const char* cA = (const char*)g.A + (size_t)cur.pm * tstep; const char* cB = (const char*)g.Bt + (size_t)cur.pn * tstep;
    S.a_ready(cur);
    if constexpr (SP2) {
        PG8_STAGE(PG8_SB(0, 0), cB, voffB); PG8_STAGE(PG8_SB(0, 1), cB + hstep, voffB); PG8_STAGE(PG8_SA(0, 0), cA, voffA); PG8_STAGE(PG8_SA(0, 1), cA + hstep, voffA);
        if (wr == 1) PG8_BAR;
        PG8_WAIT_V(2); PG8_BAR;
        PG8_STAGE(PG8_SB(1, 0), cB + kstep, voffB); PG8_STAGE(PG8_SA(1, 0), cA + kstep, voffA); PG8_STAGE(PG8_SB(1, 1), cB + hstep + kstep, voffB);
        PG8_WAIT_V(6); PG8_BAR;
    } else {
        PG8_STAGE(PG8_SB(0, 0), cB, voffB); PG8_STAGE(PG8_SA(0, 0), cA, voffA); PG8_STAGE(PG8_SB(0, 1), cB + hstep, voffB); PG8_STAGE(PG8_SA(0, 1), cA + hstep, voffA);
        if (wr == 1) PG8_BAR;
        PG8_WAIT_V(4); PG8_BAR;
        PG8_STAGE(PG8_SB(1, 0), cB + kstep, voffB); PG8_STAGE(PG8_SA(1, 0), cA + kstep, voffA); PG8_STAGE(PG8_SB(1, 1), cB + hstep + kstep, voffB);
        PG8_WAIT_V(6); PG8_BAR;
    }
    for (;;) {
        const bool has_next = S.next(ui + 1, nxt);
        const char* nA = has_next ? (const char*)g.A + (size_t)nxt.pm * tstep : cA; const char* nB = has_next ? (const char*)g.Bt + (size_t)nxt.pn * tstep : cB;
#pragma unroll 1
        for (int t = 0; t < nt; t += 2) {
            if constexpr (FP8) asm volatile("" : "+v"(voffA[0]), "+v"(voffA[1]), "+v"(voffB[0]), "+v"(voffB[1]));
            const bool last = (t == nt - 2);
            const char* a1 = cA + (size_t)(t + 1) * kstep;
            const char* a2 = last ? nA : cA + (size_t)(t + 2) * kstep; const char* b2 = last ? nB : cB + (size_t)(t + 2) * kstep;
            const char* a3 = a2 + kstep; const char* b3 = b2 + kstep;
            if (last && has_next) S.a_ready(nxt);
            if constexpr (SP2) {
            PG8_LDB(B0, 0, 0); PG8_LDB(B1, 0, 1); PG8_SCHED; PG8_LDA(At, 0, 0); PG8_STAGE(PG8_SA(1, 1), a1 + hstep, voffA);
            PG8_WAIT_V(8); PG8_WAIT_L(0); PG8_BAR; PG8_MMA(0, 0, At, B0); PG8_MMA(0, 1, At, B1); PG8_BAR; PG8_SCHED;
            PG8_LDA(At, 0, 1); PG8_STAGE(PG8_SB(0, 0), b2, voffB); PG8_STAGE(PG8_SB(0, 1), b2 + hstep, voffB); PG8_STAGE(PG8_SA(0, 0), a2, voffA);
            PG8_WAIT_V(8); PG8_WAIT_L(0); PG8_BAR; PG8_MMA(1, 0, At, B0); PG8_MMA(1, 1, At, B1); PG8_BAR; PG8_SCHED;
            PG8_LDB(B0, 1, 0); PG8_LDB(B1, 1, 1); PG8_SCHED; PG8_LDA(At, 1, 0); PG8_STAGE(PG8_SA(0, 1), a2 + hstep, voffA);
            PG8_WAIT_V(8); PG8_WAIT_L(0); PG8_BAR; PG8_MMA(0, 0, At, B0); PG8_MMA(0, 1, At, B1); PG8_BAR; PG8_SCHED;
            PG8_LDA(At, 1, 1); PG8_STAGE(PG8_SB(1, 0), b3, voffB); PG8_STAGE(PG8_SB(1, 1), b3 + hstep, voffB); PG8_STAGE(PG8_SA(1, 0), a3, voffA);
            PG8_WAIT_V(8); PG8_WAIT_L(0); PG8_BAR; PG8_MMA(1, 0, At, B0); PG8_MMA(1, 1, At, B1); PG8_BAR; PG8_SCHED;
            } else {
            PG8_LDB(B0, 0, 0); PG8_SCHED; PG8_LDA(At, 0, 0); PG8_STAGE(PG8_SA(1, 1), a1 + hstep, voffA);
            PG8_WAIT_L(8); PG8_BAR; PG8_WAIT_L(0); PG8_MMA(0, 0, At, B0); PG8_BAR; PG8_SCHED;
            PG8_LDB(B1, 0, 1); PG8_STAGE(PG8_SB(0, 0), b2, voffB);
            PG8_BAR; PG8_WAIT_L(0); PG8_MMA(0, 1, At, B1); PG8_BAR;
            PG8_LDA(At, 0, 1); PG8_STAGE(PG8_SA(0, 0), a2, voffA);
            PG8_BAR; PG8_WAIT_L(0); PG8_MMA(1, 0, At, B0); PG8_BAR; PG8_SCHED;
            PG8_STAGE(PG8_SB(0, 1), b2 + hstep, voffB);
            PG8_WAIT_V(6); PG8_BAR; PG8_MMA(1, 1, At, B1); PG8_BAR;
            PG8_LDB(B0, 1, 0); PG8_SCHED; PG8_LDA(At, 1, 0); PG8_STAGE(PG8_SA(0, 1), a2 + hstep, voffA);
            PG8_WAIT_L(8); PG8_BAR; PG8_WAIT_L(0); PG8_MMA(0, 0, At, B0); PG8_BAR; PG8_SCHED;
            PG8_LDB(B1, 1, 1); PG8_STAGE(PG8_SB(1, 0), b3, voffB);
            PG8_BAR; PG8_WAIT_L(0); PG8_MMA(0, 1, At, B1); PG8_BAR;
            PG8_LDA(At, 1, 1); PG8_STAGE(PG8_SA(1, 0), a3, voffA);
            PG8_BAR; PG8_WAIT_L(0); PG8_MMA(1, 0, At, B0); PG8_BAR; PG8_SCHED;
            PG8_STAGE(PG8_SB(1, 1), b3 + hstep, voffB);
            PG8_WAIT_V(6); PG8_BAR; PG8_MMA(1, 1, At, B1); PG8_BAR;
            }
        }
        if constexpr (ALIGN_EPI) { if (wr == 0) PG8_BAR; }
        if constexpr (!Epi::AFTER_DRAIN) { int ln_; asm volatile("v_mbcnt_lo_u32_b32 %0, -1, 0\n\tv_mbcnt_hi_u32_b32 %0, -1, %0" : "=v"(ln_));
            E(acc, cur, wr, wc, ln_ & 15, ln_ >> 4); S.done(cur); }
        if (!has_next) break;
#pragma unroll
        for (int a = 0; a < 2; ++a)
#pragma unroll
            for (int b = 0; b < 2; ++b)
#pragma unroll
                for (int m = 0; m < 4; ++m)
#pragma unroll
                    for (int n = 0; n < 2; ++n) acc[a][b][m][n] = (f32x4){0.f, 0.f, 0.f, 0.f};
        cur = nxt; cA = nA; cB = nB; ++ui;
        if constexpr (ALIGN_EPI) { if (wr == 1) PG8_BAR; }
    }
    PG8_WAIT_V(0);
    if constexpr (!ALIGN_EPI) { if (wr == 0) PG8_BAR; }
    PG8_BAR;
    if constexpr (Epi::AFTER_DRAIN) { E.fused(acc, cur, wr, wc, fr, fq, lds, wid, lane); S.done(cur); }
#undef PG8_SA
#undef PG8_SB
#undef PG8_STAGE
#undef PG8_LDA
#undef PG8_LDB
#undef PG8_MMA
#undef PG8_WAIT_V
#undef PG8_WAIT_L
#undef PG8_BAR
#undef PG8_SCHED
}
}
#define GAS __attribute__((address_space(1)))
#define LAS __attribute__((address_space(3)))
typedef unsigned short bf16;
typedef unsigned v4u __attribute__((ext_vector_type(4)));
typedef float f32x4 __attribute__((ext_vector_type(4)));
typedef short bf16x8 __attribute__((ext_vector_type(8)));
typedef GAS unsigned gu32;
typedef GAS unsigned long long gu64;
#define RLX_AGENT __ATOMIC_RELAXED, __HIP_MEMORY_SCOPE_AGENT
#define LDS_WAIT() asm volatile("s_waitcnt lgkmcnt(0)" ::: "memory")
#define VM_WAIT() asm volatile("s_waitcnt vmcnt(0)" ::: "memory")
__device__ __forceinline__ unsigned long long rt() { return __builtin_amdgcn_s_memrealtime(); }
__device__ __forceinline__ unsigned f2bf(float f) { unsigned u = __builtin_bit_cast(unsigned, f); return (u + 0x7fffu + ((u >> 16) & 1u)) >> 16; }
__device__ __forceinline__ unsigned pk2(float lo, float hi) { return f2bf(lo) | (f2bf(hi) << 16); }

#define XB_TMO      128
#define XB_XCNT(j)  (256  + 64 * (j))
#define XB_XSUB(j)  (1280 + 64 * (j))
#define XB_XGEN(j)  (2304 + 64 * (j))
#define XB_TOP      3328
#define XB_TOPGEN   3392
#define XCD_BAR_WORDS 3456
#define XB_SPIN_CAP (1u << 18)

__device__ __forceinline__ unsigned xb_ld(unsigned* p)              { return __hip_atomic_load(p, __ATOMIC_RELAXED, __HIP_MEMORY_SCOPE_AGENT); }
__device__ __forceinline__ unsigned xb_add(unsigned* p, unsigned v) { return __hip_atomic_fetch_add(p, v, __ATOMIC_RELAXED, __HIP_MEMORY_SCOPE_AGENT); }
__device__ __forceinline__ unsigned xb_xcc_id() { return (unsigned)__builtin_amdgcn_s_getreg((3 << 11) | 20) & 0xFu; }
#define XB_SPIN(cond, bar) do { unsigned _sp = 0; while (cond) { __builtin_amdgcn_s_sleep(1); \
    if ((++_sp & 255u) == 0u) { if (xb_ld(&(bar)[XB_TMO])) break; if (_sp > XB_SPIN_CAP) { atomicAdd(&(bar)[XB_TMO], 1u); break; } } } } while (0)

struct XcdBarrier {
    unsigned* bar; unsigned x;
    volatile LAS unsigned* st;
};

__device__ __forceinline__ XcdBarrier xcd_barrier_post(unsigned* bar, volatile LAS unsigned* st) {
    XcdBarrier b; b.bar = bar; b.x = xb_xcc_id(); b.st = st;
    if (threadIdx.x == 0) (void)xb_add(&bar[XB_XCNT(b.x)], 1u);
    return b;
}
__device__ __forceinline__ void xcd_barrier_complete(unsigned* bar, unsigned x, unsigned& nloc, unsigned& nx) {
    const unsigned G = gridDim.x * gridDim.y * gridDim.z;
    unsigned sum, cnt, mine, sp = 0u;
    for (;;) {
        sum = 0u; cnt = 0u; mine = 0u;
#pragma unroll
        for (unsigned j = 0; j < 16; ++j) { const unsigned c = xb_ld(&bar[XB_XCNT(j)]); sum += c; cnt += (c > 0u) ? 1u : 0u; mine = (j == x) ? c : mine; }
        if (sum == G) break;
        __builtin_amdgcn_s_sleep(1);
        if ((++sp & 255u) == 0u) { if (xb_ld(&bar[XB_TMO])) break; if (sp > XB_SPIN_CAP) { atomicAdd(&bar[XB_TMO], 1u); break; } }
    }
    nloc = mine > 0u ? mine : 1u; nx = cnt > 0u ? cnt : 1u;
}

__device__ __forceinline__ void xcd_barrier(const XcdBarrier& b) {
    asm volatile("s_waitcnt vmcnt(0)" ::: "memory");
    __syncthreads();
    if (threadIdx.x == 0) {
        unsigned* bar = b.bar;
        __builtin_amdgcn_s_waitcnt(0);
        unsigned nloc = b.st[0], nx = b.st[1];
        if (nloc == 0u) { xcd_barrier_complete(bar, b.x, nloc, nx); b.st[0] = nloc; b.st[1] = nx; }
        const unsigned old = xb_add(&bar[XB_XSUB(b.x)], 1u);
        const unsigned gen = old / nloc;
        if (old + 1u == (gen + 1u) * nloc) {
            __builtin_amdgcn_fence(__ATOMIC_RELEASE, "agent");
            asm volatile("s_waitcnt vmcnt(0)" ::: "memory");
            const unsigned og = xb_add(&bar[XB_TOP], 1u);
            const unsigned tg = og / nx;
            if (og + 1u == (tg + 1u) * nx) xb_add(&bar[XB_TOPGEN], 1u);
            else XB_SPIN(xb_ld(&bar[XB_TOPGEN]) == tg, bar);
            __builtin_amdgcn_fence(__ATOMIC_ACQUIRE, "agent");
            xb_add(&bar[XB_XGEN(b.x)], 1u);
            asm volatile("s_waitcnt vmcnt(0)" ::: "memory");
        } else {
            XB_SPIN(xb_ld(&bar[XB_XGEN(b.x)]) == gen, bar);
            __builtin_amdgcn_fence(__ATOMIC_ACQUIRE, "agent");
            asm volatile("s_waitcnt vmcnt(0)" ::: "memory");
        }
    }
    __syncthreads();
}
__device__ __forceinline__ void xcd_barrier_w(const XcdBarrier& b, bool is_t0) {
    asm volatile("s_waitcnt vmcnt(0)" ::: "memory");
    __syncthreads();
    if (is_t0) {
        unsigned* bar = b.bar;
        __builtin_amdgcn_s_waitcnt(0);
        unsigned nloc = b.st[0], nx = b.st[1];
        if (nloc == 0u) { xcd_barrier_complete(bar, b.x, nloc, nx); b.st[0] = nloc; b.st[1] = nx; }
        const unsigned old = xb_add(&bar[XB_XSUB(b.x)], 1u);
        const unsigned gen = old / nloc;
        if (old + 1u == (gen + 1u) * nloc) {
            __builtin_amdgcn_fence(__ATOMIC_RELEASE, "agent");
            asm volatile("s_waitcnt vmcnt(0)" ::: "memory");
            const unsigned og = xb_add(&bar[XB_TOP], 1u);
            const unsigned tg = og / nx;
            if (og + 1u == (tg + 1u) * nx) xb_add(&bar[XB_TOPGEN], 1u);
            else XB_SPIN(xb_ld(&bar[XB_TOPGEN]) == tg, bar);
            __builtin_amdgcn_fence(__ATOMIC_ACQUIRE, "agent");
            xb_add(&bar[XB_XGEN(b.x)], 1u);
            asm volatile("s_waitcnt vmcnt(0)" ::: "memory");
        } else {
            XB_SPIN(xb_ld(&bar[XB_XGEN(b.x)]) == gen, bar);
            __builtin_amdgcn_fence(__ATOMIC_ACQUIRE, "agent");
            asm volatile("s_waitcnt vmcnt(0)" ::: "memory");
        }
    }
    __syncthreads();
}
#define PROBE_KIND -1
#define PROBE_MULT 4
#define PROBE_B2 0
#define PROBE_PRO 0
#define PROBE_UP 0
#define PROBE_CMP 0
#define PROBE_PREP 0
#define PROBE_LN 0
#define PROBE_BAR 0
#define PROBE_GN 0
#define PROBE_DOWN 0
#define PROBE_ATT 0
#define PROBE_SOLO -1
#define PROBE_IDXMODE 0
#ifndef FAST_NSA
#define FAST_NSA 1
#endif
#ifndef FAST_SB
#define FAST_SB 1
#endif
#ifndef FAST_DSA
#define FAST_DSA 1
#endif
constexpr int NWAVES = 8, NTHR = 512;
constexpr int BATCH = 16, SEQ = 2048, DM = 1024, FF = 2816, M = BATCH * SEQ, DEPTH = 2;
constexpr int NH = 3584;
constexpr int DIN = 2516;
constexpr int HC_CQ = 0, HC_CKV = 256, HC_KROPE = 384, HC_GATE = 416, HC_IDXW = 428, HC_IDXK = 448, HC_QEFF = 512, HC_KVEFF = 896,
              HC_NSAQ = 1408, HC_KCMP = 1664, HC_VCMP = 1728, HC_KSLC = 1792, HC_VSLC = 1856, HC_KWIN = 1920, HC_VWIN = 1984,
              HC_DSAQ = 2048, HC_DSAK = 2304, HC_DSAV = 2368, HC_IDXQ = 2432, HC_SBQ = 2688, HC_SBK = 2944, HC_SBV = 3200;
constexpr int SC_CQ = 0, SC_CKV = 256, SC_KROPE = 384, SC_NSAQ = 416, SC_KCMP = 672, SC_GATE = 1056, SC_DSAQ = 1068, SC_DSAK = 1324,
              SC_IDXQ = 1452, SC_IDXK = 1708, SC_IDXW = 1740, SC_SBQ = 1748;
constexpr float LN_EPS = 1e-5f, RMS_EPS = 1e-6f;
constexpr float DN_ALPHA = 1.4142135623730951f;
constexpr float LOG2E = 1.4426950408889634f;
constexpr float QSC_MLA = 0.10206207261596577f * LOG2E;
constexpr float QSC_64 = 0.125f * LOG2E;
constexpr float W13_SCALE = 128.f, W2_SCALE = 512.f;
enum { I_X = 0, I_LN1G, I_LN1B, I_F1W1, I_F1W3, I_F1W2, I_WIN, I_QNORM, I_WUQ, I_KVNORM, I_WUKV, I_CMPPOS, I_WK1, I_WK2, I_WV1, I_WV2, I_GNG, I_WOUT,
       I_LN2G, I_LN2B, I_F2W1, I_F2W3, I_F2W2, I_LN3G, I_LN3B, N_IN };
constexpr size_t MiB = 1u << 20;
constexpr size_t WS_CTL = 0, CTL_ZERO_BYTES = 64 * 1024;
constexpr size_t WS_TAB = 1 * MiB;
constexpr size_t WS_T32 = WS_TAB + 512 * 1024, WS_CBIAS = WS_TAB + 768 * 1024;
constexpr size_t WS_KC = 2 * MiB;
constexpr size_t WS_SUMSQ = 3 * MiB;
constexpr size_t WS_BITM = 5 * MiB;
constexpr size_t WS_CW1 = 13 * MiB;
constexpr size_t WS_W = 16 * MiB, W_LAYER = 42 * MiB;
constexpr size_t WO_13A = 0, WO_2A = 11 * MiB, WO_13B = 11 * MiB + 5632 * 1024, WO_2B = 27 * MiB + 512 * 1024, WO_IN = 33 * MiB, WO_OUT = 40 * MiB;
constexpr size_t WS_XB = 104 * MiB;
constexpr size_t WS_YCAT = 168 * MiB;
constexpr size_t WS_BIG = 232 * MiB;
constexpr size_t WS_END = 456 * MiB;
constexpr size_t WS_XQ8 = WS_BIG + 128 * MiB;
static_assert(WO_2A == (size_t)5632 * 1024 * 2 && WO_13B == WO_2A + (size_t)1024 * 2816 * 2 && WO_2B == WO_13B + WO_2A && WO_IN == WO_2B + (size_t)1024 * 2816 * 2 && WO_OUT == WO_IN + (size_t)NH * 1024 * 2 && W_LAYER == WO_OUT + 2 * MiB, "weights map");
static_assert(WS_W + 2 * W_LAYER <= WS_XB && WS_XB + (size_t)M * DM * 2 == WS_YCAT && WS_YCAT + (size_t)M * DM * 2 == WS_BIG && WS_BIG + (size_t)M * NH * 2 == WS_END, "ws map");
constexpr int CW_BAR = 1024, CW_QUEUE = 8192;
constexpr int RING_BYTES = 131072, MISC_OFF = RING_BYTES + 320, LDS_BYTES = 147456;
#undef XB_SPIN_CAP
#define XB_SPIN_CAP (1u << 23)
typedef float f32x16 __attribute__((ext_vector_type(16)));
typedef float f32x2 __attribute__((ext_vector_type(2)));
typedef unsigned u32x4 __attribute__((ext_vector_type(4)));
__device__ __forceinline__ float bf2f(unsigned short u) { return __uint_as_float((unsigned)u << 16); }
__device__ __forceinline__ float bflo(unsigned u) { return __uint_as_float(u << 16); }
__device__ __forceinline__ float bfhi(unsigned u) { return __uint_as_float(u & 0xffff0000u); }
template <int K> __device__ __forceinline__ int sx_i(int v) { static_assert(K >= 1 && K < 32, "swizzle xor"); return __builtin_amdgcn_ds_swizzle(v, (K << 10) | 0x1f); }
template <int K> __device__ __forceinline__ float sx_f(float v) { return __int_as_float(sx_i<K>(__float_as_int(v))); }
__device__ __forceinline__ float x32_sum(float v) { auto rr = __builtin_amdgcn_permlane32_swap(__float_as_uint(v), __float_as_uint(v), false, false); return __uint_as_float(rr[0]) + __uint_as_float(rr[1]); }
__device__ __forceinline__ float x32_max(float v) { auto rr = __builtin_amdgcn_permlane32_swap(__float_as_uint(v), __float_as_uint(v), false, false); return fmaxf(__uint_as_float(rr[0]), __uint_as_float(rr[1])); }
__device__ __forceinline__ float x32_min(float v) { auto rr = __builtin_amdgcn_permlane32_swap(__float_as_uint(v), __float_as_uint(v), false, false); return fminf(__uint_as_float(rr[0]), __uint_as_float(rr[1])); }
__device__ __forceinline__ unsigned x32_other_u(unsigned v, int hi) { auto rr = __builtin_amdgcn_permlane32_swap(v, v, false, false); return hi ? rr[0] : rr[1]; }
__device__ __forceinline__ float x32_other(float v, int hi) { return __uint_as_float(x32_other_u(__float_as_uint(v), hi)); }
#define DPP_I(old, x, ctrl, rmask) __builtin_amdgcn_update_dpp((old), (x), (ctrl), (rmask), 0xf, false)
#define DPP_F(old, x, ctrl, rmask) __int_as_float(__builtin_amdgcn_update_dpp(__float_as_int(old), __float_as_int(x), (ctrl), (rmask), 0xf, false))
__device__ __forceinline__ float dpp_scan_sum(float v) { v += DPP_F(0.f, v, 0x111, 0xf); v += DPP_F(0.f, v, 0x112, 0xf); v += DPP_F(0.f, v, 0x114, 0xf); v += DPP_F(0.f, v, 0x118, 0xf); v += DPP_F(0.f, v, 0x142, 0xa); return v; }
__device__ __forceinline__ float dpp_scan_max(float v) { v = fmaxf(v, DPP_F(v, v, 0x111, 0xf)); v = fmaxf(v, DPP_F(v, v, 0x112, 0xf)); v = fmaxf(v, DPP_F(v, v, 0x114, 0xf)); v = fmaxf(v, DPP_F(v, v, 0x118, 0xf)); v = fmaxf(v, DPP_F(v, v, 0x142, 0xa)); return v; }
__device__ __forceinline__ float dpp_scan_min(float v) { v = fminf(v, DPP_F(v, v, 0x111, 0xf)); v = fminf(v, DPP_F(v, v, 0x112, 0xf)); v = fminf(v, DPP_F(v, v, 0x114, 0xf)); v = fminf(v, DPP_F(v, v, 0x118, 0xf)); v = fminf(v, DPP_F(v, v, 0x142, 0xa)); return v; }
__device__ __forceinline__ float rl_f(float v, int l) { return __int_as_float(__builtin_amdgcn_readlane(__float_as_int(v), l)); }
__device__ __forceinline__ float wave_sum(float v) { v = dpp_scan_sum(v); return rl_f(v, 31) + rl_f(v, 63); }
__device__ __forceinline__ float wave_max(float v) { v = dpp_scan_max(v); return fmaxf(rl_f(v, 31), rl_f(v, 63)); }
__device__ __forceinline__ float wave_min(float v) { v = dpp_scan_min(v); return fminf(rl_f(v, 31), rl_f(v, 63)); }
__device__ __forceinline__ float half_sum(float v, int hi) { v = dpp_scan_sum(v); const float a = rl_f(v, 31), b = rl_f(v, 63); return hi ? b : a; }
__device__ __forceinline__ float half_max(float v, int hi) { v = dpp_scan_max(v); const float a = rl_f(v, 31), b = rl_f(v, 63); return hi ? b : a; }
__device__ __forceinline__ float ex2(float x) { return __builtin_amdgcn_exp2f(x); }
__device__ __forceinline__ int lane_id() { int l; asm volatile("v_mbcnt_lo_u32_b32 %0, -1, 0\n\tv_mbcnt_hi_u32_b32 %0, -1, %0" : "=v"(l)); return l; }

template <class F> __device__ __forceinline__ void transpose_item(const F& val, int K, bf16* WT, LAS float* scr, int kb, int nb, int lane) {
    const int k0 = 64 * kb, n0 = 32 * nb;
    float tmp[32];
#pragma unroll
    for (int i = 0; i < 32; ++i) tmp[i] = val(k0 + 2 * i + (lane >> 5), n0 + (lane & 31));
#pragma unroll
    for (int i = 0; i < 32; ++i) scr[(2 * i + (lane >> 5)) * 33 + (lane & 31)] = tmp[i];
    LDS_WAIT(); asm volatile("" ::: "memory");
    const int c = lane & 7;
#pragma unroll
    for (int j = 0; j < 4; ++j) { const int n = (lane >> 3) + 8 * j; const LAS float* s = scr + (8 * c) * 33 + n;
        v4u o; o.x = pk2(s[0 * 33], s[1 * 33]); o.y = pk2(s[2 * 33], s[3 * 33]); o.z = pk2(s[4 * 33], s[5 * 33]); o.w = pk2(s[6 * 33], s[7 * 33]);
        *(GAS v4u*)(WT + (size_t)(n0 + n) * K + k0 + 8 * c) = o; }
    LDS_WAIT(); asm volatile("" ::: "memory");
}
template <class F> __device__ __forceinline__ void transpose_item8(const F& val, int K, unsigned char* WT8, LAS float* scr, int kb, int nb, int lane, float scale) {
    const int k0 = 64 * kb, n0 = 32 * nb;
    float tmp[32];
#pragma unroll
    for (int i = 0; i < 32; ++i) tmp[i] = val(k0 + 2 * i + (lane >> 5), n0 + (lane & 31));
#pragma unroll
    for (int i = 0; i < 32; ++i) scr[(2 * i + (lane >> 5)) * 33 + (lane & 31)] = tmp[i] * scale;
    LDS_WAIT(); asm volatile("" ::: "memory");
    const int c = lane & 7;
#pragma unroll
    for (int j = 0; j < 4; ++j) { const int n = (lane >> 3) + 8 * j; const LAS float* sp = scr + (8 * c) * 33 + n;
        int lo = __builtin_amdgcn_cvt_pk_fp8_f32(sp[0 * 33], sp[1 * 33], 0, false); lo = __builtin_amdgcn_cvt_pk_fp8_f32(sp[2 * 33], sp[3 * 33], lo, true);
        int hi = __builtin_amdgcn_cvt_pk_fp8_f32(sp[4 * 33], sp[5 * 33], 0, false); hi = __builtin_amdgcn_cvt_pk_fp8_f32(sp[6 * 33], sp[7 * 33], hi, true);
        *(GAS unsigned long long*)(WT8 + (size_t)(n0 + n) * K + k0 + 8 * c) = (unsigned long long)(unsigned)lo | ((unsigned long long)(unsigned)hi << 32); }
    LDS_WAIT(); asm volatile("" ::: "memory");
}
struct ValW13 { const float* w1; const float* w3;
    __device__ __forceinline__ float operator()(int k, int n) const { const int col = (n >> 8) * 128 + (n & 127); const uintptr_t d = (n & 128) ? ((uintptr_t)w3 - (uintptr_t)w1) : (uintptr_t)0; return ((const float*)((uintptr_t)w1 + d))[(size_t)k * FF + col]; } };
struct ValPlain { const float* w; int ld;
    __device__ __forceinline__ float operator()(int k, int n) const { return w[(size_t)k * ld + n]; } };
struct ValWout { const float* w; const float* g;
    __device__ __forceinline__ float operator()(int k, int n) const { return w[(size_t)k * DM + n] * g[k]; } };
__device__ __forceinline__ int win_src(int n) {
    if (n < 416) return n;
    if (n < 428) return SC_GATE + (n - 416);
    if (n < 436) return SC_IDXW + (n - 428);
    if (n < 448) return -1;
    if (n < 480) return SC_IDXK + (n - 448);
    if (n < 1408) return -1;
    if (n < 1664) return SC_NSAQ + (n - 1408);
    if (n < 2048) return SC_KCMP + (n - 1664);
    if (n < 2304) return SC_DSAQ + (n - 2048);
    if (n < 2432) return SC_DSAK + (n - 2304);
    if (n < 2688) return SC_IDXQ + (n - 2432);
    if (n < 3456) return SC_SBQ + (n - 2688);
    return -1;
}
struct ValWin { const float* win;
    __device__ __forceinline__ float operator()(int k, int n) const { const int s = win_src(n); return s < 0 ? 0.f : win[(size_t)k * DIN + s]; } };
__device__ __forceinline__ void merged_tile(const float* win, int src0, int nj, const float* g, const float* wu, int ldu, int c0, int k0, bf16* WTrow0  , int lane) {
    const int i = lane & 31, kk = lane >> 5;
    const float* ap = win + (size_t)(k0 + i) * DIN + src0 + kk;
    const float* bp = wu + (size_t)kk * ldu + c0 + i;
    const float* gp = g + kk;
    f32x16 acc = (f32x16){};
    for (int j = 0; j < nj; j += 16) { float av[8], bv[8];
#pragma unroll
        for (int u = 0; u < 8; ++u) { av[u] = ap[j + 2 * u]; bv[u] = bp[(size_t)(j + 2 * u) * ldu] * gp[j + 2 * u]; }
#pragma unroll
        for (int u = 0; u < 8; ++u) acc = __builtin_amdgcn_mfma_f32_32x32x2f32(av[u], bv[u], acc, 0, 0, 0); }
    bf16* wrow = WTrow0 + (size_t)i * DM + k0 + 4 * kk;
#pragma unroll
    for (int g4 = 0; g4 < 4; ++g4) *(unsigned long long*)(wrow + 8 * g4) = (unsigned long long)pk2(acc[4 * g4], acc[4 * g4 + 1]) | ((unsigned long long)pk2(acc[4 * g4 + 2], acc[4 * g4 + 3]) << 32);
}
__device__ __forceinline__ f32x2 rope_cs(int t, int i2  ) {
    double inv = 1.0; const double r = 0.7498942093324559;
    for (int q = 0; q < i2; ++q) inv *= r;
    const float ang = (float)t * (float)inv;
    const double a = (double)ang, n = __builtin_rint(a * 0.15915494309189535);
    const double rr = __builtin_fma(-n, 6.283185307179586, a);
    const float rev = (float)(rr * 0.15915494309189535);
    return (f32x2){__builtin_amdgcn_cosf(rev), __builtin_amdgcn_sinf(rev)};
}
struct P { const float* in[N_IN]; float* out; unsigned char* ws; };
#define OPAQUE_V(x) asm volatile("" : "+v"(x))
#define OPAQUE_S(x) asm volatile("" : "+s"(x))
typedef const __attribute__((address_space(4))) P* PP;
__device__ __forceinline__ PP getp() { PP q = (PP)__builtin_amdgcn_kernarg_segment_ptr(); asm volatile("" : "+s"(q)); return q; }

__device__ __forceinline__ void prologue(PP p, LAS unsigned char* ldsL, int gw, int NGW, int lane, int wave) {
    LAS float* scr = (LAS float*)(ldsL + wave * 16384);
    unsigned char* ws = p->ws;
    constexpr int IT_IN = (DM / 64) * (NH / 32), IT_13 = (DM / 64) * (2 * FF / 32), IT_2 = (FF / 64) * (DM / 32), IT_O = (DM / 64) * (DM / 32);
    constexpr int PER_L = IT_IN + 2 * IT_13 + 2 * IT_2 + IT_O;
    for (int it = gw; it < DEPTH * PER_L; it += NGW) {
        const int l = it / PER_L; int r = it % PER_L;
        unsigned char* wl = ws + WS_W + (size_t)l * W_LAYER;
        if (r < IT_IN) { const int nb = r / (DM / 64); if (nb < HC_QEFF / 32 || nb >= HC_NSAQ / 32) { ValWin v{p->in[I_WIN] + (size_t)l * DM * DIN}; transpose_item(v, DM, (bf16*)(wl + WO_IN), scr, r % (DM / 64), nb, lane); } continue; } r -= IT_IN;
        if (r < IT_13) { ValW13 v{p->in[I_F1W1] + (size_t)l * DM * FF, p->in[I_F1W3] + (size_t)l * DM * FF}; transpose_item8(v, DM, wl + WO_13A, scr, r % (DM / 64), r / (DM / 64), lane, W13_SCALE); continue; } r -= IT_13;
        if (r < IT_13) { ValW13 v{p->in[I_F2W1] + (size_t)l * DM * FF, p->in[I_F2W3] + (size_t)l * DM * FF}; transpose_item8(v, DM, wl + WO_13B, scr, r % (DM / 64), r / (DM / 64), lane, W13_SCALE); continue; } r -= IT_13;
        if (r < IT_2) { ValPlain v{p->in[I_F1W2] + (size_t)l * FF * DM, DM}; transpose_item8(v, FF, wl + WO_2A, scr, r % (FF / 64), r / (FF / 64), lane, W2_SCALE); continue; } r -= IT_2;
        if (r < IT_2) { ValPlain v{p->in[I_F2W2] + (size_t)l * FF * DM, DM}; transpose_item8(v, FF, wl + WO_2B, scr, r % (FF / 64), r / (FF / 64), lane, W2_SCALE); continue; } r -= IT_2;
        { ValWout v{p->in[I_WOUT] + (size_t)l * DM * DM, p->in[I_GNG] + l * DM}; transpose_item(v, DM, (bf16*)(wl + WO_OUT), scr, r % (DM / 64), r / (DM / 64), lane); }
    }
    for (int it = gw; it < DEPTH * 32 * 28; it += NGW) { const int l = it / (32 * 28), r = it % (32 * 28), kb = r % 32, cb = r / 32;
        const float* win = p->in[I_WIN] + (size_t)l * DM * DIN; bf16* WT = (bf16*)(ws + WS_W + (size_t)l * W_LAYER + WO_IN);
        if (cb < 12) merged_tile(win, SC_CQ, 256, p->in[I_QNORM] + l * 256, p->in[I_WUQ] + (size_t)l * 256 * 384, 384, cb * 32, kb * 32, WT + (size_t)(HC_QEFF + cb * 32) * DM, lane);
        else merged_tile(win, SC_CKV, 128, p->in[I_KVNORM] + l * 128, p->in[I_WUKV] + (size_t)l * 128 * 512, 512, (cb - 12) * 32, kb * 32, WT + (size_t)(HC_KVEFF + (cb - 12) * 32) * DM, lane); }
    for (int it = gw; it < 4 * 64; it += NGW) { const int mi = it >> 6, r = it & 63; ValPlain v{p->in[(mi & 1) ? I_WV1 : I_WK1] + (size_t)(mi >> 1) * 2048 * 64, 64};
        transpose_item(v, 2048, (bf16*)(ws + WS_CW1) + (size_t)mi * 64 * 2048, scr, r & 31, r >> 5, lane); }
    { f32x2* T64 = (f32x2*)(ws + WS_TAB); f32x2* T32 = (f32x2*)(ws + WS_T32);
      for (int e = gw * 64 + lane; e < SEQ * 32; e += NGW * 64) T64[e] = rope_cs(e >> 5, e & 31);
      for (int e = gw * 64 + lane; e < SEQ * 16; e += NGW * 64) T32[e] = rope_cs(e >> 4, 2 * (e & 15)); }
    if (gw < 128) { const int mi = gw >> 5, part = gw & 31, l = mi >> 1, kv = mi & 1; const float* pos = p->in[I_CMPPOS] + (size_t)l * 2048 + part * 64; const float* w1 = p->in[kv ? I_WV1 : I_WK1] + (size_t)l * 2048 * 64 + (size_t)part * 64 * 64;
        float a = 0.f;
#pragma unroll 16
        for (int r = 0; r < 64; ++r) a += pos[r] * w1[r * 64 + lane];
        ((float*)(ws + WS_CBIAS))[(mi * 32 + part) * 64 + lane] = a; }
    { const f32x4* x4 = (const f32x4*)p->in[I_X]; unsigned long long* o8 = (unsigned long long*)(ws + WS_XB);
      unsigned* q4 = (unsigned*)(ws + WS_XQ8);
      constexpr int UX = 8; const size_t stride = (size_t)NGW * 64, total = (size_t)M * DM / 4;
      for (size_t e0 = (size_t)gw * 64 + lane; e0 < total; e0 += UX * stride) { f32x4 v[UX];
#pragma unroll
          for (int u = 0; u < UX; ++u) { const size_t e = e0 + u * stride; v[u] = x4[e < total ? e : e0]; }
#pragma unroll
          for (int u = 0; u < UX; ++u) { const size_t e = e0 + u * stride; if (e < total) { o8[e] = (unsigned long long)pk2(v[u].x, v[u].y) | ((unsigned long long)pk2(v[u].z, v[u].w) << 32);
              int q = __builtin_amdgcn_cvt_pk_fp8_f32(v[u].x, v[u].y, 0, false); q = __builtin_amdgcn_cvt_pk_fp8_f32(v[u].z, v[u].w, q, true); q4[e] = (unsigned)q; } } } }
}

__device__ __forceinline__ void ln_phase(bf16* xb, float* fout, const float* g, const float* b, int gw, int NGW, int lane, unsigned char* xq8 = nullptr) {
    constexpr int U = 4;
    f32x4 gg[4], bb[4];
#pragma unroll
    for (int j = 0; j < 4; ++j) { const int c = (j >> 1) * 512 + 8 * lane + (j & 1) * 4; gg[j] = *(const f32x4*)(g + c); bb[j] = *(const f32x4*)(b + c); }
    for (int m0 = gw; m0 < M; m0 += U * NGW) {
        u32x4 raw[U][2];
#pragma unroll
        for (int u = 0; u < U; ++u) { const int m = (m0 + u * NGW < M) ? m0 + u * NGW : m0; const u32x4* xr = (const u32x4*)(xb + (size_t)m * DM) + lane; raw[u][0] = xr[0]; raw[u][1] = xr[64]; }
#pragma unroll
        for (int u = 0; u < U; ++u) { const int m = m0 + u * NGW; if (m >= M) break;
            float v[16];
#pragma unroll
            for (int h = 0; h < 2; ++h)
#pragma unroll
                for (int k = 0; k < 4; ++k) { v[h * 8 + 2 * k] = bflo(raw[u][h][k]); v[h * 8 + 2 * k + 1] = bfhi(raw[u][h][k]); }
            float s = 0.f;
#pragma unroll
            for (int k = 0; k < 16; ++k) s += v[k];
            const float mean = wave_sum(s) * (1.f / DM); float s2 = 0.f;
#pragma unroll
            for (int k = 0; k < 16; ++k) { v[k] -= mean; s2 += v[k] * v[k]; }
            const float rstd = 1.f / sqrtf(wave_sum(s2) * (1.f / DM) + LN_EPS);
#pragma unroll
            for (int k = 0; k < 16; ++k) v[k] = v[k] * rstd * gg[k >> 2][k & 3] + bb[k >> 2][k & 3];
            u32x4* xw = (u32x4*)(xb + (size_t)m * DM) + lane;
#pragma unroll
            for (int h = 0; h < 2; ++h) { u32x4 w; w.x = pk2(v[h * 8], v[h * 8 + 1]); w.y = pk2(v[h * 8 + 2], v[h * 8 + 3]); w.z = pk2(v[h * 8 + 4], v[h * 8 + 5]); w.w = pk2(v[h * 8 + 6], v[h * 8 + 7]); xw[64 * h] = w; }
            if (xq8) { unsigned long long* qw = (unsigned long long*)(xq8 + (size_t)m * DM) + lane;
#pragma unroll
                for (int h = 0; h < 2; ++h) { int lo = __builtin_amdgcn_cvt_pk_fp8_f32(v[h * 8], v[h * 8 + 1], 0, false); lo = __builtin_amdgcn_cvt_pk_fp8_f32(v[h * 8 + 2], v[h * 8 + 3], lo, true);
                    int hi = __builtin_amdgcn_cvt_pk_fp8_f32(v[h * 8 + 4], v[h * 8 + 5], 0, false); hi = __builtin_amdgcn_cvt_pk_fp8_f32(v[h * 8 + 6], v[h * 8 + 7], hi, true);
                    qw[64 * h] = (unsigned long long)(unsigned)lo | ((unsigned long long)(unsigned)hi << 32); } }
            if (fout) { f32x4* fo = (f32x4*)(fout + (size_t)m * DM + 8 * lane);
#pragma unroll
                for (int h = 0; h < 2; ++h) { fo[128 * h] = (f32x4){v[h * 8], v[h * 8 + 1], v[h * 8 + 2], v[h * 8 + 3]}; fo[128 * h + 1] = (f32x4){v[h * 8 + 4], v[h * 8 + 5], v[h * 8 + 6], v[h * 8 + 7]}; } }
        }
    }
}
__device__ __forceinline__ void rope_inplace(bf16* hr, int c0, int nh, int half, const f32x2* trow, float f, int lane) {
    for (int pi = lane; pi < nh * half; pi += 64) { const int hd = pi / half, i = pi % half; bf16* q = hr + c0 + hd * 2 * half + i;
        const float z1 = bf2f(q[0]), z2 = bf2f(q[half]); const f32x2 cs = trow[i];
        q[0] = (bf16)f2bf((z1 * cs.x - z2 * cs.y) * f); q[half] = (bf16)f2bf((z1 * cs.y + z2 * cs.x) * f); }
}
__device__ __forceinline__ void scale_inplace(bf16* hr, int c0, int n, float f, int lane) {
    for (int c = 2 * lane; c < n; c += 128) { unsigned* q = (unsigned*)(hr + c0 + c); const unsigned u = *q; *q = pk2(bflo(u) * f, bfhi(u) * f); }
}
__device__ __forceinline__ void prep_token(bf16* hr, int t, const f32x2* T64, const f32x2* T32, int lane) {
    float sq = 0.f, skv = 0.f;
    { const unsigned long long u = *((const unsigned long long*)(hr + HC_CQ) + lane); const unsigned a = (unsigned)u, b = (unsigned)(u >> 32);
      sq = bflo(a) * bflo(a) + bfhi(a) * bfhi(a) + bflo(b) * bflo(b) + bfhi(b) * bfhi(b);
      const unsigned c = *((const unsigned*)(hr + HC_CKV) + lane); skv = bflo(c) * bflo(c) + bfhi(c) * bfhi(c); }
    const float rq = 1.0f / sqrtf(wave_sum(sq) * (1.f / 256.f) + RMS_EPS), rkv = 1.0f / sqrtf(wave_sum(skv) * (1.f / 128.f) + RMS_EPS);
    const f32x2* t64 = T64 + t * 32; const f32x2* t32 = T32 + t * 16;
    for (int e = lane; e < 256; e += 64) { bf16* q = hr + HC_QEFF + (e >> 6) * 96 + (e & 63); *q = (bf16)f2bf(bf2f(*q) * (rq * QSC_MLA)); }
    for (int hd = 0; hd < 4; ++hd) rope_inplace(hr, HC_QEFF + hd * 96 + 64, 1, 16, t32, rq * QSC_MLA, lane);
    scale_inplace(hr, HC_KVEFF, 512, rkv, lane);
    rope_inplace(hr, HC_KROPE, 1, 16, t32, 1.f, lane);
    rope_inplace(hr, HC_NSAQ, 4, 32, t64, QSC_64, lane);
    rope_inplace(hr, HC_KCMP, 1, 32, t64, 1.f, lane);
    rope_inplace(hr, HC_KSLC, 1, 32, t64, 1.f, lane);
    rope_inplace(hr, HC_KWIN, 1, 32, t64, 1.f, lane);
    rope_inplace(hr, HC_DSAQ, 4, 32, t64, QSC_64, lane);
    rope_inplace(hr, HC_DSAK, 1, 32, t64, 1.f, lane);
    rope_inplace(hr, HC_IDXQ, 8, 16, t32, 1.f, lane);
    rope_inplace(hr, HC_IDXK, 1, 16, t32, 1.f, lane);
    if (lane < 12) { bf16* q = hr + HC_GATE + lane; *q = (bf16)f2bf(1.0f / (1.0f + __expf(-bf2f(*q)))); }
    else if (lane < 20) { bf16* q = hr + HC_IDXW + (lane - 12); *q = (bf16)f2bf(bf2f(*q) * 0.0625f); }
    scale_inplace(hr, HC_SBQ, 256, 0.125f, lane);
}
struct PrepCls { int type; float f; int fi; };
__device__ __forceinline__ PrepCls prep_classify(int k, int L, float rqf, float rkv) {
    PrepCls c; c.type = 0; c.f = 1.f; c.fi = 0;
    const int d64 = (8 * L) & 63, d32 = (8 * L) & 31;
    const int r64 = (d64 & 31) | ((d64 >= 32) ? 256 : 0), r32v = (d32 & 15) | ((d32 >= 16) ? 256 : 0);
    if (k == 0) { if ((L >= 48 && L < 52) || (L >= 56 && L < 60)) { c.type = 3; c.fi = r32v; } else if (L >= 52 && L < 55) c.type = 4; }
    else if (k == 1) { if (L < 48) { const int d = (8 * L) % 96; c.f = rqf; if (d < 64) c.type = 1; else { c.type = 3; c.fi = ((d - 64) & 15) | ((d >= 80) ? 256 : 0); } } else { c.type = 1; c.f = rkv; } }
    else if (k == 2) { if (L < 48) { c.type = 1; c.f = rkv; } else { c.type = 2; c.f = QSC_64; c.fi = r64; } }
    else if (k == 3) { if (L < 16) { c.type = 2; c.f = QSC_64; c.fi = r64; } else if (((L >> 3) & 1) == 0) { c.type = 2; c.fi = r64; } }
    else if (k == 4) { if (L < 32) { c.type = 2; c.f = QSC_64; c.fi = r64; } else if (L < 40) { c.type = 2; c.fi = r64; } else if (L >= 48) { c.type = 3; c.fi = r32v; } }
    else { if (L < 16) { c.type = 3; c.fi = r32v; } else if (L < 48) { c.type = 1; c.f = 0.125f; } }
    return c;
}
__device__ __forceinline__ void prep_load(const bf16* hr, u32x4 (&raw)[6], int lane) {
#pragma unroll
    for (int k = 0; k < 6; ++k) raw[k] = *((const u32x4*)(hr + 512 * k) + lane);
}
__device__ __forceinline__ void prep_row(bf16* hr, u32x4 (&raw)[6], int t, const f32x2* T64, const f32x2* T32, int lane) {
    float ss = 0.f;
#pragma unroll
    for (int j = 0; j < 4; ++j) { const float a = bflo(raw[0][j]), b = bfhi(raw[0][j]); ss += a * a + b * b; }
    const float rq = 1.0f / sqrtf(wave_sum(lane < 32 ? ss : 0.f) * (1.f / 256.f) + RMS_EPS), rkv = 1.0f / sqrtf(wave_sum((lane >= 32 && lane < 48) ? ss : 0.f) * (1.f / 128.f) + RMS_EPS);
#pragma unroll
    for (int k = 0; k < 6; ++k) {
        const PrepCls c = prep_classify(k, lane, rq * QSC_MLA, rkv);
        const bool rope = (c.type == 2 || c.type == 3);
        const f32x2* tp = (c.type == 2) ? (T64 + t * 32 + (c.fi & 255)) : (T32 + t * 16 + ((c.type == 3) ? (c.fi & 255) : 0));
        f32x4 cs[4];
#pragma unroll
        for (int j = 0; j < 4; ++j) cs[j] = ((const f32x4*)tp)[j];
        u32x4 p4, p2;
#pragma unroll
        for (int j = 0; j < 4; ++j) { p4[j] = (unsigned)sx_i<4>((int)raw[k][j]); p2[j] = (unsigned)sx_i<2>((int)raw[k][j]); }
        const u32x4 pr = (c.type == 2) ? p4 : p2;
        const bool second = (c.fi & 256) != 0;
        float o[8];
#pragma unroll
        for (int j = 0; j < 4; ++j) {
#pragma unroll
            for (int e = 0; e < 2; ++e) { const float z = e ? bfhi(raw[k][j]) : bflo(raw[k][j]), zp = e ? bfhi(pr[j]) : bflo(pr[j]);
                const float cc = cs[j][2 * e], sn = cs[j][2 * e + 1];
                float v = z * c.f;
                if (rope) v = (second ? (zp * sn + z * cc) : (z * cc - zp * sn)) * c.f;
                o[2 * j + e] = v; } }
        if (c.type == 4) {
#pragma unroll
            for (int e = 0; e < 8; ++e) { const float z = (e & 1) ? bfhi(raw[k][e >> 1]) : bflo(raw[k][e >> 1]); const int col = 8 * lane + e;
                o[e] = (col < HC_IDXW) ? 1.0f / (1.0f + __expf(-z)) : (col < HC_IDXW + 8 ? z * 0.0625f : z); } }
        if (c.type != 0) { u32x4 w; w.x = pk2(o[0], o[1]); w.y = pk2(o[2], o[3]); w.z = pk2(o[4], o[5]); w.w = pk2(o[6], o[7]); *((u32x4*)(hr + 512 * k) + lane) = w; }
    }
}
__device__ __forceinline__ void compress_item(PP p, int l, int item, LAS float* zs  , int lane) {
    const int kv = item / (BATCH * 128), rem = item % (BATCH * 128), b = rem / 128, n = rem % 128;
    if (n == 127) { ((bf16*)(p->ws + WS_KC))[((size_t)(kv * BATCH + b) * 128 + 127) * 64 + lane] = 0; return; }
    const bf16* hb = (const bf16*)(p->ws + WS_BIG) + (size_t)b * SEQ * NH + (kv ? HC_VCMP : HC_KCMP);
    const f32x2* T64 = (const f32x2*)(p->ws + WS_TAB);
    for (int i = 0; i < 32; ++i) { const int t = 16 * n + i; const bf16* zr = hb + (size_t)t * NH; float v;
        if (kv) v = bf2f(zr[lane]);
        else { const int fi = lane & 31; const f32x2 cs = T64[t * 32 + fi]; const float z1 = bf2f(zr[fi]), z2 = bf2f(zr[fi + 32]); v = (lane < 32) ? (z1 * cs.x - z2 * cs.y) : (z1 * cs.y + z2 * cs.x); }
        zs[i * 64 + lane] = v; }
    LDS_WAIT(); asm volatile("" ::: "memory");
    const float* w1 = p->in[kv ? I_WV1 : I_WK1] + (size_t)l * 2048 * 64; const float* w2 = p->in[kv ? I_WV2 : I_WK2] + (size_t)l * 64 * 64;
    float a = 0.f; for (int pp = 0; pp < 32; ++pp) a += ((const float*)(p->ws + WS_CBIAS))[((l * 2 + kv) * 32 + pp) * 64 + lane];
    for (int r = 0; r < 2048; r += 4) { const f32x4 z = *(const LAS f32x4*)(zs + r);
        a += z.x * w1[(r + 0) * 64 + lane]; a += z.y * w1[(r + 1) * 64 + lane]; a += z.z * w1[(r + 2) * 64 + lane]; a += z.w * w1[(r + 3) * 64 + lane]; }
    { const float u = 0.7978845608028654f * (a + 0.044715f * a * a * a); const float th = 1.0f - 2.0f / (__expf(2.0f * u) + 1.0f); a = 0.5f * a * (1.0f + th); }
    float o = 0.f;
    for (int j = 0; j < 64; ++j) o += __shfl(a, j) * w2[j * 64 + lane];
    bf16* kc = (bf16*)(p->ws + WS_KC) + ((size_t)(kv * BATCH + b) * 128 + n) * 64;
    kc[lane] = (bf16)f2bf(o);
    LDS_WAIT(); asm volatile("" ::: "memory");
}
template <int N> __device__ __forceinline__ float dot_row(const LAS float* q, const bf16* k) {
    float s = 0.f;
#pragma unroll 2
    for (int c = 0; c < N; c += 8) { const v4u kv = *(const v4u*)(k + c); const f32x4 q0 = *(const LAS f32x4*)(q + c), q1 = *(const LAS f32x4*)(q + c + 4);
        s += q0.x * bflo(kv.x) + q0.y * bfhi(kv.x) + q0.z * bflo(kv.y) + q0.w * bfhi(kv.y) + q1.x * bflo(kv.z) + q1.y * bfhi(kv.z) + q1.z * bflo(kv.w) + q1.w * bfhi(kv.w); }
    return s;
}
template <int DQ1, int DQ2, class Valid>
__device__ __forceinline__ float attn_naive(const LAS float* qs, const bf16* k1, const bf16* k2, const bf16* v, int ldk, int jlo, int jhi, const Valid& valid, int lane, float& l_out) {
    float m = -INFINITY, l = 0.f, o = 0.f;
    for (int j0 = jlo; j0 <= jhi; j0 += 64) {
        const int key = j0 + lane; const bool ok = valid(key);
        unsigned long long bal = __ballot(ok);
        if (bal == 0ull) continue;
        float s = -INFINITY;
        if (ok) { s = dot_row<DQ1>(qs, k1 + (size_t)key * ldk); if constexpr (DQ2 > 0) s += dot_row<DQ2>(qs + DQ1, k2 + (size_t)key * ldk); }
        const float mn = fmaxf(m, wave_max(s)), al = ex2(m - mn), pr = ok ? ex2(s - mn) : 0.f;
        l = l * al + wave_sum(pr); o *= al; m = mn;
        while (bal) { const int jj = __builtin_ctzll(bal); bal &= bal - 1ull; o += __shfl(pr, jj) * bf2f(v[(size_t)(j0 + jj) * ldk + lane]); }
    }
    l_out = l; return o;
}
__device__ __forceinline__ void put_y(bf16* ycat, float* sumsq, int token, int g, int hd, float val, int lane) {
    ycat[(size_t)token * DM + g * 256 + hd * 64 + lane] = (bf16)f2bf(val);
}
__device__ __forceinline__ unsigned dsa_select(const bf16* hb, const bf16* hr, int t, LAS float* ws_, unsigned* bm, int lane_in) {
    int lane = lane_in; OPAQUE_V(lane);
    LAS float* qi = ws_; LAS float* wq = ws_ + 256; LAS float* sc = ws_ + 1024;
    for (int c = lane; c < 256; c += 64) qi[c] = bf2f(hr[HC_IDXQ + c]);
    if (lane < 8) wq[lane] = bf2f(hr[HC_IDXW + lane]);
    LDS_WAIT(); asm volatile("" ::: "memory");
    const int nt = (t >> 6) + 1;
    for (int i = 0; i < nt; ++i) { const int key = 64 * i + lane; const bf16* kr = hb + (size_t)key * NH + HC_IDXK; float acc = 0.f;
#pragma unroll 1
        for (int hh = 0; hh < 8; ++hh) acc += wq[hh] * fmaxf(dot_row<32>(qi + hh * 32, kr), 0.f);
        sc[key] = (key <= t) ? acc : -3.0e38f; }
    LDS_WAIT(); asm volatile("" ::: "memory");
    float v[32];
#pragma unroll
    for (int i = 0; i < 32; ++i) v[i] = (i < nt) ? sc[i * 64 + lane] : -3.0e38f;
    float thr = -3.0e38f; bool tie = false; int need = 0;
    const bool all = (t < 256);
    if (!all) {
#define CNT_GE(x, c) do { c = 0; _Pragma("unroll") for (int i_ = 0; i_ < 32; ++i_) c += __builtin_popcountll(__ballot(v[i_] >= (x))); } while (0)
#define CNT_GT(x, c) do { c = 0; _Pragma("unroll") for (int i_ = 0; i_ < 32; ++i_) c += __builtin_popcountll(__ballot(v[i_] > (x))); } while (0)
        float mx = -3.0e38f, mn = 3.0e38f;
#pragma unroll
        for (int i = 0; i < 32; ++i) { mx = fmaxf(mx, v[i]); mn = fminf(mn, (v[i] > -1.0e38f) ? v[i] : 3.0e38f); }
        float hi = wave_max(mx), lo = wave_min(mn); int c;
        CNT_GE(hi, c);
        if (c >= 256) { thr = hi; tie = (c > 256); }
        else for (;;) { const float mid = 0.5f * (lo + hi);
            if (!(mid > lo && mid < hi)) { thr = lo; tie = true; break; }
            CNT_GE(mid, c);
            if (c == 256) { thr = mid; break; }
            if (c > 256) lo = mid; else hi = mid; }
        if (tie) { CNT_GT(thr, c); need = 256 - c; }
#undef CNT_GE
#undef CNT_GT
    }
    unsigned sel = 0u;
#pragma unroll
    for (int i = 0; i < 32; ++i) {
        unsigned long long mask;
        if (all) mask = __ballot(64 * i + lane <= t);
        else { const unsigned long long gt = __ballot(v[i] > thr), eq = __ballot(v[i] == thr); unsigned long long take = eq;
            if (tie) { const int ce = __builtin_popcountll(eq); if (ce <= need) need -= ce; else { unsigned long long mm = eq; take = 0ull; for (int q = 0; q < need; ++q) { const unsigned long long bb = mm & (~mm + 1ull); take |= bb; mm ^= bb; } need = 0; } }
            mask = gt | take; }
        if (lane < 2) bm[2 * i + lane] = (unsigned)(mask >> (32 * lane));
        sel |= (unsigned)((mask >> lane) & 1ull) << i;
    }
    return sel;
}
__device__ __forceinline__ unsigned nsa_cmp_select(const bf16* hr, const bf16* kcb, const bf16* vcb, int t, LAS float* scr, LAS float* oc, int lane) {
    LAS float* qs = scr; LAS float* ps = scr + 64;
    const int nvis = (t >= 31) ? (((t - 31) >> 4) + 1) : 0;
    float ps0 = 0.f, ps1 = 0.f;
    for (int hd = 0; hd < 4; ++hd) {
        qs[lane] = bf2f(hr[HC_NSAQ + 64 * hd + lane]);
        LDS_WAIT(); asm volatile("" ::: "memory");
        float p0 = 0.f, p1 = 0.f, o = 0.f;
        if (nvis > 0) {
            const float s0 = (lane < nvis) ? dot_row<64>(qs, kcb + lane * 64) : -INFINITY, s1 = (64 + lane < nvis) ? dot_row<64>(qs, kcb + (64 + lane) * 64) : -INFINITY;
            const float mx = wave_max(fmaxf(s0, s1));
            p0 = (lane < nvis) ? ex2(s0 - mx) : 0.f; p1 = (64 + lane < nvis) ? ex2(s1 - mx) : 0.f;
            const float inv = 1.0f / fmaxf(wave_sum(p0 + p1), 1e-30f); p0 *= inv; p1 *= inv;
            for (int n = 0; n < nvis; ++n) { const float pn = (n < 64) ? __shfl(p0, n) : __shfl(p1, n - 64); o += pn * bf2f(vcb[n * 64 + lane]); }
        }
        ps0 += p0; ps1 += p1; oc[hd * 64 + lane] = o;
        LDS_WAIT(); asm volatile("" ::: "memory");
    }
    ps[lane] = ps0; ps[64 + lane] = ps1;
    LDS_WAIT(); asm volatile("" ::: "memory");
    const int cur = t >> 6;
    float val = -3.4e38f;
    if (lane < 32) { float imp = 0.f;
        for (int n = 4 * lane - 1; n <= 4 * lane + 3; ++n) if (n >= 0 && n <= 126) imp += ps[n];
        val = (lane == 0 || lane == cur || lane == cur - 1) ? 1.0e4f : ((lane <= cur) ? imp : -1.0e30f); }
    unsigned selmask = 0u;
    for (int r = 0; r < 8; ++r) { const float mx = wave_max(val); const unsigned long long bal = __ballot(val == mx); const int first = __builtin_ctzll(bal);
        selmask |= 1u << first; if (lane == first) val = -3.4e38f; }
    return selmask;
}
template <int GROUPS  >
__device__ __forceinline__ void attn_token_naive(PP p, int token, LAS float* ws_, int lane_in) {
    int lane = lane_in; OPAQUE_V(lane);
    const int b = token / SEQ, t = token % SEQ;
    const bf16* hb = (const bf16*)(p->ws + WS_BIG) + (size_t)b * SEQ * NH; const bf16* hr = hb + (size_t)t * NH;
    bf16* ycat = (bf16*)(p->ws + WS_YCAT); float* sumsq = (float*)(p->ws + WS_SUMSQ);
    LAS float* qs = ws_;
    if constexpr (GROUPS & 1) for (int hd = 0; hd < 4; ++hd) {
        for (int c = lane; c < 96; c += 64) qs[c] = bf2f(hr[HC_QEFF + 96 * hd + c]);
        LDS_WAIT(); asm volatile("" ::: "memory");
        float l; const float o = attn_naive<64, 32>(qs, hb + HC_KVEFF + 128 * hd, hb + HC_KROPE, hb + HC_KVEFF + 128 * hd + 64, NH, 0, t & ~63, [t](int key) { return key <= t; }, lane, l);
        put_y(ycat, sumsq, token, 0, hd, o / fmaxf(l, 1e-30f), lane);
        LDS_WAIT(); asm volatile("" ::: "memory");
    }
    if constexpr (GROUPS & 2) for (int hd = 0; hd < 4; ++hd) {
        qs[lane] = bf2f(hr[HC_SBQ + 64 * hd + lane]);
        LDS_WAIT(); asm volatile("" ::: "memory");
        float o = 0.f, carry = 0.f;
        if (t > 0) for (int j0 = (t - 1) & ~63; j0 >= 0; j0 -= 64) {
            const int key = j0 + lane; const bool ok = key < t;
            const float z = ok ? dot_row<64>(qs, hb + (size_t)key * NH + HC_SBK + 64 * hd) : 0.f;
            const float lm = ok ? -(fmaxf(z, 0.f) + __logf(1.0f + __expf(-fabsf(z)))) : 0.f;
            float incl = lm;
#pragma unroll
            for (int off = 1; off < 64; off <<= 1) { const float u = __shfl_down(incl, off); if (lane + off < 64) incl += u; }
            const float a = ok ? __expf(z + incl + carry) : 0.f;
            carry += __shfl(incl, 0);
            unsigned long long bal = __ballot(ok);
            while (bal) { const int jj = __builtin_ctzll(bal); bal &= bal - 1ull; o += __shfl(a, jj) * bf2f(hb[(size_t)(j0 + jj) * NH + HC_SBV + 64 * hd + lane]); }
            if (carry < -104.f) break;
        }
        put_y(ycat, sumsq, token, 3, hd, o, lane);
        LDS_WAIT(); asm volatile("" ::: "memory");
    }
    if constexpr (GROUPS & 4) {
        const bf16* kcb = (const bf16*)(p->ws + WS_KC) + (size_t)b * 128 * 64; const bf16* vcb = kcb + (size_t)BATCH * 128 * 64;
        const unsigned selmask = nsa_cmp_select(hr, kcb, vcb, t, ws_, ws_ + 512, lane);
        LAS float* oc = ws_ + 512;
        for (int hd = 0; hd < 4; ++hd) {
            qs[lane] = bf2f(hr[HC_NSAQ + 64 * hd + lane]);
            LDS_WAIT(); asm volatile("" ::: "memory");
            float ls, lw;
            const float os = attn_naive<64, 0>(qs, hb + HC_KSLC, nullptr, hb + HC_VSLC, NH, 0, t & ~63, [t, selmask](int key) { return key <= t && ((selmask >> (key >> 6)) & 1u); }, lane, ls);
            const int klo = t - 511;
            const float ow = attn_naive<64, 0>(qs, hb + HC_KWIN, nullptr, hb + HC_VWIN, NH, (klo > 0 ? klo : 0) & ~63, t & ~63, [t, klo](int key) { return key <= t && key >= klo; }, lane, lw);
            const float g0 = bf2f(hr[HC_GATE + hd]), g1 = bf2f(hr[HC_GATE + 4 + hd]), g2 = bf2f(hr[HC_GATE + 8 + hd]);
            put_y(ycat, sumsq, token, 1, hd, g0 * oc[hd * 64 + lane] + g1 * os / fmaxf(ls, 1e-30f) + g2 * ow / fmaxf(lw, 1e-30f), lane);
            LDS_WAIT(); asm volatile("" ::: "memory");
        }
    }
    if constexpr (GROUPS & 8) {
        const unsigned sel = dsa_select(hb, hr, t, ws_, (unsigned*)(p->ws + WS_BITM) + (size_t)token * 64, lane);
        for (int hd = 0; hd < 4; ++hd) {
            qs[lane] = bf2f(hr[HC_DSAQ + 64 * hd + lane]);
            LDS_WAIT(); asm volatile("" ::: "memory");
            float l; const float o = attn_naive<64, 0>(qs, hb + HC_DSAK, nullptr, hb + HC_DSAV, NH, 0, t & ~63, [sel](int key) { return ((sel >> (key >> 6)) & 1u) != 0u; }, lane, l);
            put_y(ycat, sumsq, token, 2, hd, o / fmaxf(l, 1e-30f), lane);
            LDS_WAIT(); asm volatile("" ::: "memory");
        }
    }
}
__device__ __forceinline__ void gnorm_phase(bf16* yc, int gw, int NGW, int lane) {
    constexpr int U = 4;
    for (int m0 = gw; m0 < M; m0 += U * NGW) {
        u32x4 raw[U][2];
#pragma unroll
        for (int u = 0; u < U; ++u) { const int m = (m0 + u * NGW < M) ? m0 + u * NGW : m0; const u32x4* xr = (const u32x4*)(yc + (size_t)m * DM) + lane; raw[u][0] = xr[0]; raw[u][1] = xr[64]; }
#pragma unroll
        for (int u = 0; u < U; ++u) { const int m = m0 + u * NGW; if (m >= M) break;
            u32x4* xw = (u32x4*)(yc + (size_t)m * DM) + lane;
#pragma unroll
            for (int h = 0; h < 2; ++h) { float v[8], ss = 0.f;
#pragma unroll
                for (int k = 0; k < 4; ++k) { v[2 * k] = bflo(raw[u][h][k]); v[2 * k + 1] = bfhi(raw[u][h][k]); }
#pragma unroll
                for (int k = 0; k < 8; ++k) ss += v[k] * v[k];
                ss = half_sum(ss, lane >> 5);
                const float rs = 1.0f / sqrtf(ss * (1.f / 256.f) + RMS_EPS);
                u32x4 w; w.x = pk2(v[0] * rs, v[1] * rs); w.y = pk2(v[2] * rs, v[3] * rs); w.z = pk2(v[4] * rs, v[5] * rs); w.w = pk2(v[6] * rs, v[7] * rs); xw[64 * h] = w; }
        }
    }
}
namespace fa {
typedef short s16x4 __attribute__((ext_vector_type(4)));
typedef short v4i16_t __attribute__((ext_vector_type(4)));
__device__ __forceinline__ int crow(int r, int hi) { return (r & 3) + 8 * (r >> 2) + 4 * hi; }
__device__ __forceinline__ unsigned cvtpk(float lo, float hi) { unsigned r; asm("v_cvt_pk_bf16_f32 %0, %1, %2" : "=v"(r) : "v"(lo), "v"(hi)); return r; }
template <int DQK> struct Stage { static constexpr int KB = DQK * 128, VB = 8192, BYTES = KB + VB; };
template <int DQK> struct Loader {
    v4u k0, k1, v;
    __device__ __forceinline__ void issue(const bf16* k1b, const bf16* k2b, const bf16* vb, int ld, int key0, int tid) {
        const int row = tid & 63, ch = tid >> 6;
        { const int kr = 8 * ch + (row >> 3), sl = row & 7; k0 = *(const v4u*)(k1b + (size_t)(key0 + kr) * ld + ((sl ^ ((kr >> 1) & 7)) << 3)); }
        if constexpr (DQK == 96) { if (tid < 256) { const int kr = 16 * ch + (row >> 2), sl = row & 3; k1 = *(const v4u*)(k2b + (size_t)(key0 + kr) * ld + ((sl ^ ((kr >> 2) & 3)) << 3)); } }
        v = *(const v4u*)(vb + (size_t)(key0 + 16 * (ch & 3) + (row >> 2)) * ld + (ch >> 2) * 32 + (row & 3) * 8);
    }
    __device__ __forceinline__ void commit(LAS unsigned char* st, int tid) {
        *(LAS v4u*)(st + tid * 16) = k0;
        if constexpr (DQK == 96) { if (tid < 256) *(LAS v4u*)(st + 8192 + tid * 16) = k1; }
        *(LAS v4u*)(st + Stage<DQK>::KB + tid * 16) = v;
    }
};
template <int DQK> __device__ __forceinline__ void qk_tile(f32x16& p0, f32x16& p1, const LAS unsigned char* kst, const bf16x8 (&qr)[DQK / 16], int r32, int hi, const f32x16& cinit) {
    const LAS unsigned char* kb = kst + r32 * 128; const int x7 = hi ^ ((r32 >> 1) & 7);
#pragma unroll
    for (int d0 = 0; d0 < 4; ++d0) { const LAS unsigned char* q = kb + (((2 * d0) ^ x7) << 4); const bf16x8 b0 = *(const LAS bf16x8*)q, b1 = *(const LAS bf16x8*)(q + 4096);
        if (d0 == 0) { p0 = __builtin_amdgcn_mfma_f32_32x32x16_bf16(b0, qr[0], cinit, 0, 0, 0); p1 = __builtin_amdgcn_mfma_f32_32x32x16_bf16(b1, qr[0], cinit, 0, 0, 0); }
        else { p0 = __builtin_amdgcn_mfma_f32_32x32x16_bf16(b0, qr[d0], p0, 0, 0, 0); p1 = __builtin_amdgcn_mfma_f32_32x32x16_bf16(b1, qr[d0], p1, 0, 0, 0); } }
    if constexpr (DQK == 96) { const LAS unsigned char* kp = kst + 8192 + r32 * 64; const int x3 = hi ^ ((r32 >> 2) & 3);
#pragma unroll
        for (int d0 = 0; d0 < 2; ++d0) { const LAS unsigned char* q = kp + (((2 * d0) ^ x3) << 4); const bf16x8 b0 = *(const LAS bf16x8*)q, b1 = *(const LAS bf16x8*)(q + 2048);
            p0 = __builtin_amdgcn_mfma_f32_32x32x16_bf16(b0, qr[4 + d0], p0, 0, 0, 0); p1 = __builtin_amdgcn_mfma_f32_32x32x16_bf16(b1, qr[4 + d0], p1, 0, 0, 0); } }
}
template <int DQK> __device__ __forceinline__ void qk_tile(f32x16& p0, f32x16& p1, const LAS unsigned char* kst, const bf16x8 (&qr)[DQK / 16], int r32, int hi) {
    f32x16 z = (f32x16){}; qk_tile<DQK>(p0, p1, kst, qr, r32, hi, z);
}
__device__ __forceinline__ void pv_tile(f32x16 (&o)[2], const LAS unsigned char* vst, const f32x16& p0, const f32x16& p1, int lane) {
    const int hi = lane >> 5;
    u32x4 pw[4];
#pragma unroll
    for (int j = 0; j < 4; ++j) { pw[0][j] = cvtpk(p0[2 * j], p0[2 * j + 1]); pw[1][j] = cvtpk(p0[8 + 2 * j], p0[9 + 2 * j]); pw[2][j] = cvtpk(p1[2 * j], p1[2 * j + 1]); pw[3][j] = cvtpk(p1[8 + 2 * j], p1[9 + 2 * j]); }
    const LAS unsigned char* vp = vst + ((lane >> 4) & 1) * 32 + (lane & 3) * 8 + (4 * hi + ((lane & 15) >> 2)) * 64;
#pragma unroll
    for (int d0 = 0; d0 < 2; ++d0)
#pragma unroll
        for (int ks = 0; ks < 4; ++ks) {
            const s16x4 lo = __builtin_bit_cast(s16x4, __builtin_amdgcn_ds_read_tr16_b64_v4i16((LAS v4i16_t*)(vp + d0 * 4096 + ks * 1024)));
            const s16x4 hh = __builtin_bit_cast(s16x4, __builtin_amdgcn_ds_read_tr16_b64_v4i16((LAS v4i16_t*)(vp + d0 * 4096 + ks * 1024 + 512)));
            const bf16x8 vf = (bf16x8){lo[0], lo[1], lo[2], lo[3], hh[0], hh[1], hh[2], hh[3]};
            o[d0] = __builtin_amdgcn_mfma_f32_32x32x16_bf16(__builtin_bit_cast(bf16x8, pw[ks]), vf, o[d0], 0, 0, 0); }
}
__device__ __forceinline__ void softmax_tile(f32x16& p0, f32x16& p1, f32x16 (&o)[2], float& m, float& l, LAS float* wsf, int r32, int hi) {
    float mx = fmaxf(p0[0], p1[0]);
#pragma unroll
    for (int r = 1; r < 16; ++r) mx = fmaxf(mx, fmaxf(p0[r], p1[r]));
    mx = x32_max(mx);
    const float mn = (mx > m + 8.0f) ? mx : m, ms = (mn == -INFINITY) ? 0.f : mn, f = ex2(m - ms);
    float s = 0.f;
#pragma unroll
    for (int r = 0; r < 16; ++r) { p0[r] = ex2(p0[r] - ms); p1[r] = ex2(p1[r] - ms); s += p0[r] + p1[r]; }
    l = l * f + s; m = mn;
    if (__any(f != 1.0f)) {
        if (hi == 0) wsf[r32] = f;
        asm volatile("s_waitcnt lgkmcnt(0)" ::: "memory");
#pragma unroll
        for (int r = 0; r < 16; ++r) { const float fr = wsf[crow(r, hi)]; o[0][r] *= fr; o[1][r] *= fr; }
        asm volatile("s_waitcnt lgkmcnt(0)" ::: "memory");
    }
}
__device__ __forceinline__ float max3f(float a, float b, float c) { float r; asm("v_max3_f32 %0, %1, %2, %3" : "=v"(r) : "v"(a), "v"(b), "v"(c)); return r; }
__device__ __forceinline__ float max2f(float a, float b) { float r; asm("v_max_f32_e32 %0, %1, %2" : "=v"(r) : "v"(a), "v"(b)); return r; }
#define FA_MX3(a, b, c) __builtin_fmaxf(__builtin_fmaxf((a), (b)), (c))
__device__ __forceinline__ void softmax_tile2(f32x16& p0, f32x16& p1, f32x16 (&o)[2], float& mref, float& l, f32x16& negm, LAS float* wsf, int r32, int hi) {
    float a = FA_MX3(p0[0], p0[1], p1[0]), b = FA_MX3(p0[2], p0[3], p1[1]); a = FA_MX3(a, p1[2], p1[3]);
#pragma unroll
    for (int r = 4; r < 16; r += 4) { a = FA_MX3(a, p0[r], p0[r + 1]); b = FA_MX3(b, p0[r + 2], p0[r + 3]); a = FA_MX3(a, p1[r], p1[r + 1]); b = FA_MX3(b, p1[r + 2], p1[r + 3]); }
    const float mx = x32_max(__builtin_fmaxf(a, b));
    const bool unset = (mref == -INFINITY), shift = (mx > 8.0f) || (unset && mx > -INFINITY);
    if (__any(shift)) {
        const float dl = shift ? mx : 0.f, f = unset ? 1.0f : ex2(-dl);
#pragma unroll
        for (int r = 0; r < 16; ++r) { p0[r] -= dl; p1[r] -= dl; }
        mref = (unset ? 0.f : mref) + dl; if (!shift && unset) mref = -INFINITY;
        const float nm = (mref == -INFINITY) ? 0.f : -mref;
#pragma unroll
        for (int r = 0; r < 16; ++r) negm[r] = nm;
        l *= f;
        if (hi == 0) wsf[r32] = f;
        asm volatile("s_waitcnt lgkmcnt(0)" ::: "memory");
#pragma unroll
        for (int r = 0; r < 16; ++r) { const float fr = wsf[crow(r, hi)]; o[0][r] *= fr; o[1][r] *= fr; }
        asm volatile("s_waitcnt lgkmcnt(0)" ::: "memory");
    }
    f32x2 s2 = (f32x2){0.f, 0.f};
#pragma unroll
    for (int r = 0; r < 16; r += 2) { p0[r] = ex2(p0[r]); p0[r + 1] = ex2(p0[r + 1]); p1[r] = ex2(p1[r]); p1[r + 1] = ex2(p1[r + 1]); s2 += (f32x2){p0[r], p0[r + 1]}; s2 += (f32x2){p1[r], p1[r + 1]}; }
    l += s2[0] + s2[1];
}
__device__ __forceinline__ void softmax_tile3(f32x16& p0, f32x16& p1, f32x16 (&o)[2], float& mref, float& l, f32x16& negm, bool& shifted, LAS float* wsf, int r32, int hi) {
    float a = FA_MX3(p0[0], p0[1], p1[0]), b = FA_MX3(p0[2], p0[3], p1[1]); a = FA_MX3(a, p1[2], p1[3]);
#pragma unroll
    for (int r = 4; r < 16; r += 4) { a = FA_MX3(a, p0[r], p0[r + 1]); b = FA_MX3(b, p0[r + 2], p0[r + 3]); a = FA_MX3(a, p1[r], p1[r + 1]); b = FA_MX3(b, p1[r + 2], p1[r + 3]); }
    const float mx = x32_max(__builtin_fmaxf(a, b));
    const bool need = (mx > 8.0f) || (l == 0.f && mx < -40.0f && mx > -INFINITY);
    if (__any(need)) {
        const float dl = need ? mx : 0.f, f = ex2(-dl);
#pragma unroll
        for (int r = 0; r < 16; ++r) { p0[r] -= dl; p1[r] -= dl; }
        mref += dl;
#pragma unroll
        for (int r = 0; r < 16; ++r) negm[r] = -mref;
        l *= f;
        if (hi == 0) wsf[r32] = f;
        asm volatile("s_waitcnt lgkmcnt(0)" ::: "memory");
#pragma unroll
        for (int r = 0; r < 16; ++r) { const float fr = wsf[crow(r, hi)]; o[0][r] *= fr; o[1][r] *= fr; }
        asm volatile("s_waitcnt lgkmcnt(0)" ::: "memory");
        shifted = true;
    }
    f32x2 s2 = (f32x2){0.f, 0.f};
#pragma unroll
    for (int r = 0; r < 16; r += 2) { p0[r] = ex2(p0[r]); p0[r + 1] = ex2(p0[r + 1]); p1[r] = ex2(p1[r]); p1[r + 1] = ex2(p1[r + 1]); s2 += (f32x2){p0[r], p0[r + 1]}; s2 += (f32x2){p1[r], p1[r + 1]}; }
    l += s2[0] + s2[1];
}
__device__ __forceinline__ void normalize_o(f32x16 (&o)[2], float l, LAS float* wsf, int r32, int hi) {
    const float lt = x32_sum(l);
    if (hi == 0) wsf[r32] = 1.0f / fmaxf(lt, 1e-30f);
    asm volatile("s_waitcnt lgkmcnt(0)" ::: "memory");
#pragma unroll
    for (int r = 0; r < 16; ++r) { const float fr = wsf[crow(r, hi)]; o[0][r] *= fr; o[1][r] *= fr; }
    asm volatile("s_waitcnt lgkmcnt(0)" ::: "memory");
}
__device__ __forceinline__ void store_o(const f32x16 (&o)[2], bf16* y, size_t row0, int ld, int col0, int r32, int hi) {
#pragma unroll
    for (int r = 0; r < 16; ++r) { bf16* yr = y + (row0 + crow(r, hi)) * ld + col0 + r32; yr[0] = (bf16)f2bf(o[0][r]); yr[32] = (bf16)f2bf(o[1][r]); }
}
template <int DQK> __device__ __forceinline__ void load_q(bf16x8 (&qr)[DQK / 16], const bf16* qrow  , int hi) {
#pragma unroll
    for (int d0 = 0; d0 < DQK / 16; ++d0) qr[d0] = *(const bf16x8*)(qrow + d0 * 16 + hi * 8);
}
}

__device__ __forceinline__ void mla_unit(const bf16* H, bf16* ycat, int b, int hd, int qb, LAS unsigned char* ldsL, int tid_in) {
    int tid = tid_in; OPAQUE_V(tid);
    const int lane = tid & 63, wave = __builtin_amdgcn_readfirstlane(tid >> 6), r32 = lane & 31, hi = lane >> 5;
    const bf16* hb = H + (size_t)b * SEQ * NH;
    const int q0w = qb * 256 + wave * 32;
    bf16x8 qr[6]; fa::load_q<96>(qr, hb + (size_t)(q0w + r32) * NH + HC_QEFF + 96 * hd, hi);
    const bf16* k1b = hb + HC_KVEFF + 128 * hd; const bf16* k2b = hb + HC_KROPE;
    const bf16* vb = k1b + 64;
    LAS float* wsf = (LAS float*)(ldsL + 2 * fa::Stage<96>::BYTES) + wave * 64;
    f32x16 o[2]; o[0] = (f32x16){}; o[1] = (f32x16){}; float m = 0.f, l = 0.f; f32x16 negm = (f32x16){}; bool shifted = false;
    const int ntiles = 4 * (qb + 1);
    fa::Loader<96> ld;
    __syncthreads();
    ld.issue(k1b, k2b, vb, NH, 0, tid); ld.commit(ldsL, tid);
    __syncthreads();
    for (int it = 0; it < ntiles; ++it) {
        const int key0 = it * 64; LAS unsigned char* st = ldsL + (it & 1) * fa::Stage<96>::BYTES;
        if (it + 1 < ntiles) ld.issue(k1b, k2b, vb, NH, key0 + 64, tid);
        if (key0 <= q0w + 31) {
            f32x16 p0, p1; if (shifted) fa::qk_tile<96>(p0, p1, st, qr, r32, hi, negm); else fa::qk_tile<96>(p0, p1, st, qr, r32, hi);
            if (key0 + 63 > q0w) { const int rel = q0w + r32 - key0 - 4 * hi;
#pragma unroll
                for (int r = 0; r < 16; ++r) { const int c = (r & 3) + 8 * (r >> 2); if (c > rel) p0[r] = -INFINITY; if (c + 32 > rel) p1[r] = -INFINITY; } }
            fa::softmax_tile3(p0, p1, o, m, l, negm, shifted, wsf, r32, hi);
            fa::pv_tile(o, st + fa::Stage<96>::KB, p0, p1, lane);
        }
        if (it + 1 < ntiles) ld.commit(ldsL + ((it + 1) & 1) * fa::Stage<96>::BYTES, tid);
        __syncthreads();
    }
    fa::normalize_o(o, l, wsf, r32, hi);
    fa::store_o(o, ycat, (size_t)b * SEQ + q0w, DM, 0 * 256 + hd * 64, r32, hi);
}
__device__ __forceinline__ void sb_unit(const bf16* H, bf16* ycat, int b, int hd, int qb, LAS unsigned char* ldsL, int tid_in) {
    int tid = tid_in; OPAQUE_V(tid);
    const int lane = tid & 63, wave = __builtin_amdgcn_readfirstlane(tid >> 6), r32 = lane & 31, hi = lane >> 5;
    const bf16* hb = H + (size_t)b * SEQ * NH;
    const int q0w = qb * 256 + wave * 32, tq = q0w + r32;
    bf16x8 qr[4]; fa::load_q<64>(qr, hb + (size_t)tq * NH + HC_SBQ + 64 * hd, hi);
    const bf16* k1b = hb + HC_SBK + 64 * hd; const bf16* vb = hb + HC_SBV + 64 * hd;
    constexpr int SB_ = fa::Stage<64>::BYTES;
    volatile LAS int* flg = (volatile LAS int*)(ldsL + 2 * SB_ + 4096);
    f32x16 o[2]; o[0] = (f32x16){}; o[1] = (f32x16){}; float carry = 1.0f; bool done = false;
    const int tmax = 4 * qb + 3;
    fa::Loader<64> ld;
    __syncthreads();
    ld.issue(k1b, nullptr, vb, NH, tmax * 64, tid); ld.commit(ldsL, tid);
    __syncthreads();
    for (int it = 0;; ++it) {
        const int key0 = (tmax - it) * 64; const bool more = key0 > 0; LAS unsigned char* st = ldsL + (it & 1) * SB_;
        if (more) ld.issue(k1b, nullptr, vb, NH, key0 - 64, tid);
        if (!done && key0 <= q0w + 30) {
            f32x16 z0, z1; fa::qk_tile<64>(z0, z1, st, qr, r32, hi);
            f32x16 M0, M1;
            const int rel = tq - key0 - 4 * hi;
#pragma unroll
            for (int r = 0; r < 16; ++r) { const int c = (r & 3) + 8 * (r >> 2);
                { const float e = ex2(fmaxf(z0[r], -80.f) * (-LOG2E)), bt = __builtin_amdgcn_rcpf(1.0f + e); const bool ok = c < rel; z0[r] = ok ? bt : 0.f; M0[r] = ok ? e * bt : 1.0f; }
                { const float e = ex2(fmaxf(z1[r], -80.f) * (-LOG2E)), bt = __builtin_amdgcn_rcpf(1.0f + e); const bool ok = c + 32 < rel; z1[r] = ok ? bt : 0.f; M1[r] = ok ? e * bt : 1.0f; } }
            float Gs[8], Go[8], SP[8];
#pragma unroll
            for (int g = 0; g < 4; ++g) { Gs[g] = (M0[4 * g] * M0[4 * g + 1]) * (M0[4 * g + 2] * M0[4 * g + 3]); Gs[4 + g] = (M1[4 * g] * M1[4 * g + 1]) * (M1[4 * g + 2] * M1[4 * g + 3]); }
#pragma unroll
            for (int j = 0; j < 8; ++j) Go[j] = x32_other(Gs[j], hi);
            SP[7] = 1.0f;
#pragma unroll
            for (int j = 6; j >= 0; --j) SP[j] = SP[j + 1] * (Gs[j + 1] * Go[j + 1]);
            const float total = SP[0] * (Gs[0] * Go[0]);
#pragma unroll
            for (int g = 0; g < 4; ++g) {
                float run0 = SP[g] * (hi == 0 ? Go[g] : 1.0f) * carry, run1 = SP[4 + g] * (hi == 0 ? Go[4 + g] : 1.0f) * carry;
#pragma unroll
                for (int i = 3; i >= 0; --i) { const int r = 4 * g + i;
                    z0[r] *= run0; run0 *= M0[r]; z1[r] *= run1; run1 *= M1[r]; }
            }
            fa::pv_tile(o, st + fa::Stage<64>::KB, z0, z1, lane);
            carry *= total;
            done = __all(carry == 0.f);
        }
        if (lane == 0) flg[(it & 1) * 8 + wave] = done ? 1 : 0;
        if (more) ld.commit(ldsL + ((it + 1) & 1) * SB_, tid);
        __syncthreads();
        int alld = 1;
#pragma unroll
        for (int w = 0; w < 8; ++w) alld &= flg[(it & 1) * 8 + w];
        if (alld || !more) break;
    }
    fa::store_o(o, ycat, (size_t)b * SEQ + q0w, DM, 3 * 256 + hd * 64, r32, hi);
}
__device__ __forceinline__ void dsa_unit(const bf16* H, const unsigned* BM, bf16* ycat, int b, int j, LAS unsigned char* ldsL, int tid_in) {
    int tid = tid_in; OPAQUE_V(tid);
    const int lane = tid & 63, wave = __builtin_amdgcn_readfirstlane(tid >> 6), r32 = lane & 31, hi = lane >> 5, qh = wave >> 2, hd = wave & 3;
    const bf16* hb = H + (size_t)b * SEQ * NH;
    const int q0w = j * 64 + qh * 32, tq = q0w + r32;
    bf16x8 qr[4]; fa::load_q<64>(qr, hb + (size_t)tq * NH + HC_DSAQ + 64 * hd, hi);
    const bf16* k1b = hb + HC_DSAK; const bf16* vb = hb + HC_DSAV;
    const unsigned* bmr = BM + ((size_t)b * SEQ + tq) * 64;
    constexpr int SB_ = fa::Stage<64>::BYTES;
    LAS float* wsf = (LAS float*)(ldsL + 2 * SB_) + wave * 64;
    f32x16 o[2]; o[0] = (f32x16){}; o[1] = (f32x16){}; float m = 0.f, l = 0.f; f32x16 negm = (f32x16){}; bool shifted = false;
    const int ntiles = j + 1;
    fa::Loader<64> ld;
    __syncthreads();
    ld.issue(k1b, nullptr, vb, NH, 0, tid); ld.commit(ldsL, tid);
    unsigned w0n = __hip_atomic_load(bmr, RLX_AGENT), w1n = __hip_atomic_load(bmr + 1, RLX_AGENT);
    __syncthreads();
    for (int it = 0; it < ntiles; ++it) {
        const int key0 = it * 64; LAS unsigned char* st = ldsL + (it & 1) * SB_;
        const unsigned w0 = w0n, w1 = w1n;
        if (it + 1 < ntiles) { ld.issue(k1b, nullptr, vb, NH, key0 + 64, tid); w0n = __hip_atomic_load(bmr + 2 * it + 2, RLX_AGENT); w1n = __hip_atomic_load(bmr + 2 * it + 3, RLX_AGENT); }
        if (__any((w0 | w1) != 0u)) {
            f32x16 p0, p1; if (shifted) fa::qk_tile<64>(p0, p1, st, qr, r32, hi, negm); else fa::qk_tile<64>(p0, p1, st, qr, r32, hi);
#pragma unroll
            for (int r = 0; r < 16; ++r) { const int kb = fa::crow(r, hi); if (!((w0 >> kb) & 1u)) p0[r] = -INFINITY; if (!((w1 >> kb) & 1u)) p1[r] = -INFINITY; }
            fa::softmax_tile3(p0, p1, o, m, l, negm, shifted, wsf, r32, hi);
            fa::pv_tile(o, st + fa::Stage<64>::KB, p0, p1, lane);
        }
        if (it + 1 < ntiles) ld.commit(ldsL + ((it + 1) & 1) * SB_, tid);
        __syncthreads();
    }
    fa::normalize_o(o, l, wsf, r32, hi);
    fa::store_o(o, ycat, (size_t)b * SEQ + q0w, DM, 2 * 256 + hd * 64, r32, hi);
}
__device__ __forceinline__ void nsa_unit(const bf16* H, const bf16* KC, bf16* ycat, int b, int j, LAS unsigned char* ldsL, int tid_in) {
    int tid = tid_in; OPAQUE_V(tid);
    const int lane = tid & 63, wave = __builtin_amdgcn_readfirstlane(tid >> 6), r32 = lane & 31, hi = lane >> 5, qh = wave >> 2, hd = wave & 3;
    const bf16* hb = H + (size_t)b * SEQ * NH;
    constexpr int SB_ = fa::Stage<64>::BYTES;
    LAS float* IMPH = (LAS float*)(ldsL + 32768);
    LAS float* wsf = (LAS float*)(ldsL + 65536) + wave * 64;
    volatile LAS unsigned* SEL = (volatile LAS unsigned*)(ldsL + 65536 + 2048);
    LAS float* GATE = (LAS float*)(ldsL + 65536 + 2048 + 256);
    const int q0w = j * 64 + qh * 32, tq = q0w + r32;
    bf16x8 qr[4]; fa::load_q<64>(qr, hb + (size_t)tq * NH + HC_NSAQ + 64 * hd, hi);
    fa::Loader<64> ld;
    f32x16 oc[2]; oc[0] = (f32x16){}; oc[1] = (f32x16){};
    __syncthreads();
    { const bf16* kcb = KC + (size_t)b * 128 * 64; const bf16* vcb = kcb + (size_t)BATCH * 128 * 64;
      ld.issue(kcb, nullptr, vcb, 64, 0, tid); ld.commit(ldsL, tid);
      ld.issue(kcb, nullptr, vcb, 64, 64, tid); ld.commit(ldsL + SB_, tid);
      for (int e = tid; e < 768; e += NTHR) GATE[e] = bf2f(hb[(size_t)(j * 64 + e / 12) * NH + HC_GATE + e % 12]);
      __syncthreads();
      const int nvis = (tq >= 31) ? (((tq - 31) >> 4) + 1) : 0; const int nv4 = nvis - 4 * hi;
      f32x16 pa0, pa1, pb0, pb1; fa::qk_tile<64>(pa0, pa1, ldsL, qr, r32, hi); fa::qk_tile<64>(pb0, pb1, ldsL + SB_, qr, r32, hi);
      float mx = -INFINITY;
#pragma unroll
      for (int r = 0; r < 16; ++r) { const int c = (r & 3) + 8 * (r >> 2);
          if (c >= nv4) pa0[r] = -INFINITY; if (c + 32 >= nv4) pa1[r] = -INFINITY; if (c + 64 >= nv4) pb0[r] = -INFINITY; if (c + 96 >= nv4) pb1[r] = -INFINITY;
          mx = fmaxf(fmaxf(mx, fmaxf(pa0[r], pa1[r])), fmaxf(pb0[r], pb1[r])); }
      mx = x32_max(mx);
      const float ms = (mx == -INFINITY) ? 0.f : mx; float sm = 0.f;
#pragma unroll
      for (int r = 0; r < 16; ++r) { pa0[r] = ex2(pa0[r] - ms); pa1[r] = ex2(pa1[r] - ms); pb0[r] = ex2(pb0[r] - ms); pb1[r] = ex2(pb1[r] - ms); sm += (pa0[r] + pa1[r]) + (pb0[r] + pb1[r]); }
      sm = x32_sum(sm);
      const float inv = 1.0f / fmaxf(sm, 1e-30f);
#pragma unroll
      for (int r = 0; r < 16; ++r) { pa0[r] *= inv; pa1[r] *= inv; pb0[r] *= inv; pb1[r] *= inv; }
      float GS[16], LE[16];
#pragma unroll
      for (int g = 0; g < 4; ++g) { GS[g] = (pa0[4 * g] + pa0[4 * g + 1]) + (pa0[4 * g + 2] + pa0[4 * g + 3]); LE[g] = pa0[4 * g + 3];
          GS[4 + g] = (pa1[4 * g] + pa1[4 * g + 1]) + (pa1[4 * g + 2] + pa1[4 * g + 3]); LE[4 + g] = pa1[4 * g + 3];
          GS[8 + g] = (pb0[4 * g] + pb0[4 * g + 1]) + (pb0[4 * g + 2] + pb0[4 * g + 3]); LE[8 + g] = pb0[4 * g + 3];
          GS[12 + g] = (pb1[4 * g] + pb1[4 * g + 1]) + (pb1[4 * g + 2] + pb1[4 * g + 3]); LE[12 + g] = pb1[4 * g + 3]; }
      float LEo[16];
#pragma unroll
      for (int k = 0; k < 16; ++k) LEo[k] = x32_other(LE[k], hi);
#pragma unroll
      for (int k = 0; k < 16; ++k) { const float prev = hi ? LEo[k] : (k > 0 ? LEo[k > 0 ? k - 1 : 0] : 0.f);
          IMPH[(hd * 32 + 2 * k + hi) * 64 + qh * 32 + r32] = GS[k] + prev; }
      fa::pv_tile(oc, ldsL + fa::Stage<64>::KB, pa0, pa1, lane);
      fa::pv_tile(oc, ldsL + SB_ + fa::Stage<64>::KB, pb0, pb1, lane);
    }
    __syncthreads();
    for (int pi = 0; pi < 4; ++pi) { const int ql = wave * 8 + pi * 2 + hi, jj = r32;
        const float imp = ((IMPH[(0 * 32 + jj) * 64 + ql] + IMPH[(1 * 32 + jj) * 64 + ql]) + IMPH[(2 * 32 + jj) * 64 + ql]) + IMPH[(3 * 32 + jj) * 64 + ql];
        float val = (jj == 0 || jj == j || jj == j - 1) ? 1.0e4f : ((jj <= j) ? imp : -1.0e30f);
        unsigned sm = 0u;
        for (int r = 0; r < 8; ++r) { const float mx = half_max(val, hi);
            const unsigned long long bal = __ballot(val == mx); const unsigned mine = hi ? (unsigned)(bal >> 32) : (unsigned)bal; const int first = __builtin_ctz(mine);
            sm |= 1u << first; if (jj == first) val = -3.4e38f; }
        if (r32 == 0) SEL[ql] = sm; }
    __syncthreads();
    unsigned um = SEL[lane];
    um |= (unsigned)sx_i<1>((int)um); um |= (unsigned)sx_i<2>((int)um); um |= (unsigned)sx_i<4>((int)um); um |= (unsigned)sx_i<8>((int)um); um |= (unsigned)sx_i<16>((int)um); um |= x32_other_u(um, hi);
    um = (unsigned)__builtin_amdgcn_readfirstlane((int)um) & ((j >= 31) ? 0xffffffffu : ((2u << j) - 1u));
    const unsigned selq = SEL[qh * 32 + r32];
    f32x16 os[2]; os[0] = (f32x16){}; os[1] = (f32x16){};
    { const bf16* k1b = hb + HC_KSLC; const bf16* vb = hb + HC_VSLC; float m = -INFINITY, l = 0.f; f32x16 negm = (f32x16){};
      int jb = __builtin_ctz(um); unsigned rest = um & (um - 1u);
      ld.issue(k1b, nullptr, vb, NH, jb * 64, tid); ld.commit(ldsL, tid);
      __syncthreads();
      for (int it = 0;; ++it) {
          const int key0 = jb * 64; LAS unsigned char* st = ldsL + (it & 1) * SB_;
          const bool more = rest != 0u; const int jn = more ? __builtin_ctz(rest) : 0;
          if (more) ld.issue(k1b, nullptr, vb, NH, jn * 64, tid);
          const bool mine = (selq >> jb) & 1u;
          if (__any(mine)) {
              f32x16 p0, p1; fa::qk_tile<64>(p0, p1, st, qr, r32, hi, negm);
              const int rel_ = mine ? (tq - key0 - 4 * hi) : -1;
#pragma unroll
              for (int r = 0; r < 16; ++r) { const int c = (r & 3) + 8 * (r >> 2); if (c > rel_) p0[r] = -INFINITY; if (c + 32 > rel_) p1[r] = -INFINITY; }
              fa::softmax_tile2(p0, p1, os, m, l, negm, wsf, r32, hi);
              fa::pv_tile(os, st + fa::Stage<64>::KB, p0, p1, lane);
          }
          if (more) ld.commit(ldsL + ((it + 1) & 1) * SB_, tid);
          __syncthreads();
          if (!more) break;
          jb = jn; rest &= rest - 1u;
      }
      fa::normalize_o(os, l, wsf, r32, hi); }
    f32x16 ow[2]; ow[0] = (f32x16){}; ow[1] = (f32x16){};
    { const bf16* k1b = hb + HC_KWIN; const bf16* vb = hb + HC_VWIN; float m = -INFINITY, l = 0.f; f32x16 negm = (f32x16){};
      const int jlo = (j >= 8) ? j - 8 : 0, ntiles = j - jlo + 1;
      ld.issue(k1b, nullptr, vb, NH, jlo * 64, tid); ld.commit(ldsL, tid);
      __syncthreads();
      for (int it = 0; it < ntiles; ++it) {
          const int key0 = (jlo + it) * 64; LAS unsigned char* st = ldsL + (it & 1) * SB_;
          if (it + 1 < ntiles) ld.issue(k1b, nullptr, vb, NH, key0 + 64, tid);
          { f32x16 p0, p1; fa::qk_tile<64>(p0, p1, st, qr, r32, hi, negm);
            if (key0 + 63 > q0w || key0 < q0w + 31 - 511) {
                const int relw_ = tq - key0 - 4 * hi;
#pragma unroll
                for (int r = 0; r < 16; ++r) { const int c = (r & 3) + 8 * (r >> 2); if (c > relw_ || c < relw_ - 511) p0[r] = -INFINITY; if (c + 32 > relw_ || c + 32 < relw_ - 511) p1[r] = -INFINITY; } }
            fa::softmax_tile2(p0, p1, ow, m, l, negm, wsf, r32, hi);
            fa::pv_tile(ow, st + fa::Stage<64>::KB, p0, p1, lane); }
          if (it + 1 < ntiles) ld.commit(ldsL + ((it + 1) & 1) * SB_, tid);
          __syncthreads();
      }
      fa::normalize_o(ow, l, wsf, r32, hi); }
#pragma unroll
    for (int r = 0; r < 16; ++r) { const int tl = qh * 32 + fa::crow(r, hi); const float g0 = GATE[tl * 12 + hd], g1 = GATE[tl * 12 + 4 + hd], g2 = GATE[tl * 12 + 8 + hd];
        os[0][r] = g0 * oc[0][r] + g1 * os[0][r] + g2 * ow[0][r];
        os[1][r] = g0 * oc[1][r] + g1 * os[1][r] + g2 * ow[1][r]; }
    fa::store_o(os, ycat, (size_t)b * SEQ + q0w, DM, 1 * 256 + hd * 64, r32, hi);
}
__device__ __forceinline__ unsigned wave_sum_u32(unsigned v) {
    int x = (int)v; x += DPP_I(0, x, 0x111, 0xf); x += DPP_I(0, x, 0x112, 0xf); x += DPP_I(0, x, 0x114, 0xf); x += DPP_I(0, x, 0x118, 0xf); x += DPP_I(0, x, 0x142, 0xa); x += DPP_I(0, x, 0x143, 0xc);
    return (unsigned)__builtin_amdgcn_readlane(x, 63);
}
__device__ __forceinline__ void topk_emit(const float (&v)[32], int t, bool all, float thr, bool tie, int need, unsigned* bm, int lane) {
    if (all) {
#pragma unroll
        for (int i = 0; i < 32; ++i) { const unsigned long long mask = __ballot(64 * i + lane <= t); if (lane < 2) bm[2 * i + lane] = (unsigned)(mask >> (32 * lane)); }
    } else if (!tie) {
#pragma unroll
        for (int i = 0; i < 32; ++i) { const unsigned long long mask = __ballot(v[i] >= thr); if (lane < 2) bm[2 * i + lane] = (unsigned)(mask >> (32 * lane)); }
    } else {
#pragma unroll
        for (int i = 0; i < 32; ++i) { const unsigned long long gt = __ballot(v[i] > thr), eq = __ballot(v[i] == thr); unsigned long long take = eq;
            const int ce = __builtin_popcountll(eq); if (ce <= need) need -= ce; else { unsigned long long mm = eq; take = 0ull; for (int q = 0; q < need; ++q) { const unsigned long long bb = mm & (~mm + 1ull); take |= bb; mm ^= bb; } need = 0; }
            const unsigned long long mask = gt | take; if (lane < 2) bm[2 * i + lane] = (unsigned)(mask >> (32 * lane)); }
    }
}
template <bool EMIT = true, int CAP = 1000> __device__ __forceinline__ void topk_rows2(const float (&v0)[32], const float (&v1)[32], int t0, int t1, unsigned* bm0, unsigned* bm1, int lane, LAS unsigned* HW, LAS float* CW) {
    const bool all0 = (t0 < 256), all1 = (t1 < 256);
    float lo0, hi0, lo1, hi1, thr0 = -3.0e38f, thr1 = -3.0e38f; bool tie0 = false, tie1 = false, done0 = all0, done1 = all1; int need0 = -1, need1 = -1;
    { float mx0 = -3.0e38f, mn0 = 3.0e38f, mx1 = -3.0e38f, mn1 = 3.0e38f;
#pragma unroll
      for (int i = 0; i < 32; ++i) { mx0 = fmaxf(mx0, v0[i]); mn0 = fminf(mn0, (v0[i] > -1.0e38f) ? v0[i] : 3.0e38f); mx1 = fmaxf(mx1, v1[i]); mn1 = fminf(mn1, (v1[i] > -1.0e38f) ? v1[i] : 3.0e38f); }
      hi0 = wave_max(mx0); lo0 = wave_min(mn0); hi1 = wave_max(mx1); lo1 = wave_min(mn1); }
    {
        const bool a0 = !done0 && (hi0 > lo0), a1 = !done1 && (hi1 > lo1);
        if (a0 || a1) {
            const int ni = __builtin_amdgcn_readfirstlane((t1 >> 6) + 1);
            const float s0 = fminf(254.5f / (hi0 - lo0), 3.0e38f), s1 = fminf(254.5f / (hi1 - lo1), 3.0e38f);
            const float c0 = a0 ? lo0 : 3.0e38f, c1 = a1 ? lo1 : 3.0e38f;
            { unsigned z_ = 0u; OPAQUE_V(z_); *(LAS v4u*)(HW + 4 * lane) = (v4u){z_, z_, z_, z_}; }
            __builtin_amdgcn_fence(__ATOMIC_RELEASE, "wavefront");
#define BIN0(x) (((x) >= c0) ? min((int)(((x) - lo0) * s0), 254) : 255)
#define BIN1(x) (((x) >= c1) ? min((int)(((x) - lo1) * s1), 254) : 255)
            unsigned pk0[8], pk1[8];
#pragma unroll
            for (int g = 0; g < 4; ++g) if (g * 8 < ni) {
#pragma unroll
                for (int j = 0; j < 8; ++j) { const int i = g * 8 + j; const unsigned b0 = (unsigned)BIN0(v0[i]), b1 = (unsigned)BIN1(v1[i]);
                    __hip_atomic_fetch_add(HW + b0, 1u, __ATOMIC_RELAXED, __HIP_MEMORY_SCOPE_WAVEFRONT);
                    __hip_atomic_fetch_add(HW + b1, 0x10000u, __ATOMIC_RELAXED, __HIP_MEMORY_SCOPE_WAVEFRONT);
                    if ((i & 3) == 0) { pk0[i >> 2] = b0; pk1[i >> 2] = b1; } else { pk0[i >> 2] |= b0 << (8 * (i & 3)); pk1[i >> 2] |= b1 << (8 * (i & 3)); } } }
            __builtin_amdgcn_fence(__ATOMIC_ACQ_REL, "wavefront");
            v4u hq = *(LAS v4u*)(HW + 4 * lane);
            if (lane == 63) hq.w = 0u;
            const unsigned sl = hq.x + hq.y + hq.z + hq.w;
            int ps = (int)sl; ps += DPP_I(0, ps, 0x111, 0xf); ps += DPP_I(0, ps, 0x112, 0xf); ps += DPP_I(0, ps, 0x114, 0xf); ps += DPP_I(0, ps, 0x118, 0xf); ps += DPP_I(0, ps, 0x142, 0xa); ps += DPP_I(0, ps, 0x143, 0xc);
            const unsigned above = (unsigned)__builtin_amdgcn_readlane(ps, 63) - (unsigned)ps;
            int B0 = -1, B1 = -1, k0 = 0, k1 = 0, n0 = 0, n1 = 0;
#define PICK(sh, act, Bx, kx, nx) do { const int ab_ = (int)((above >> (sh)) & 0xffffu), cl_ = (int)((sl >> (sh)) & 0xffffu); \
                const unsigned long long hm_ = __ballot((act) && ab_ < 256 && ab_ + cl_ >= 256); \
                if (hm_ != 0ull) { const int L_ = __builtin_ctzll(hm_); int a_ = ab_, bs_ = 0, ca_ = 0, bc_ = 0; \
                    { const int q_ = (int)((hq.w >> (sh)) & 0xffffu); if (a_ < 256 && a_ + q_ >= 256) { bs_ = 4 * lane + 3; ca_ = a_; bc_ = q_; } a_ += q_; } \
                    { const int q_ = (int)((hq.z >> (sh)) & 0xffffu); if (a_ < 256 && a_ + q_ >= 256) { bs_ = 4 * lane + 2; ca_ = a_; bc_ = q_; } a_ += q_; } \
                    { const int q_ = (int)((hq.y >> (sh)) & 0xffffu); if (a_ < 256 && a_ + q_ >= 256) { bs_ = 4 * lane + 1; ca_ = a_; bc_ = q_; } a_ += q_; } \
                    { const int q_ = (int)((hq.x >> (sh)) & 0xffffu); if (a_ < 256 && a_ + q_ >= 256) { bs_ = 4 * lane + 0; ca_ = a_; bc_ = q_; } a_ += q_; } \
                    Bx = __builtin_amdgcn_readlane(bs_, L_); kx = 256 - __builtin_amdgcn_readlane(ca_, L_); nx = __builtin_amdgcn_readlane(bc_, L_); } } while (0)
            PICK(0, a0, B0, k0, n0); PICK(16, a1, B1, k1, n1);
#undef PICK
            const bool r0 = (B0 >= 0) && n0 <= 64, r1 = (B1 >= 0) && n1 <= 64;
            if (r0 || r1) {
                const unsigned bb0 = r0 ? (unsigned)B0 : 0x1000u, bb1 = r1 ? (unsigned)B1 : 0x1000u;
                int base0 = 0, base1 = 0;
#pragma unroll
                for (int g = 0; g < 4; ++g) if (g * 8 < ni) {
#pragma unroll
                    for (int j = 0; j < 8; ++j) { const int i = g * 8 + j;
                        const bool m0 = ((pk0[i >> 2] >> (8 * (i & 3))) & 0xffu) == bb0, m1 = ((pk1[i >> 2] >> (8 * (i & 3))) & 0xffu) == bb1;
                        const unsigned long long q0 = __ballot(m0), q1 = __ballot(m1);
                        if ((q0 | q1) != 0ull) {
                            if (m0) CW[base0 + (int)__builtin_amdgcn_mbcnt_hi((unsigned)(q0 >> 32), __builtin_amdgcn_mbcnt_lo((unsigned)q0, 0u))] = v0[i];
                            if (m1) CW[64 + base1 + (int)__builtin_amdgcn_mbcnt_hi((unsigned)(q1 >> 32), __builtin_amdgcn_mbcnt_lo((unsigned)q1, 0u))] = v1[i];
                            base0 += __builtin_popcountll(q0); base1 += __builtin_popcountll(q1); } } }
                __builtin_amdgcn_fence(__ATOMIC_ACQ_REL, "wavefront");
#define RANK(rx, nx, kx, off, thrx, tiex, needx, donex) do { if (rx) { const float c_ = (lane < (nx)) ? CW[(off) + lane] : -3.0e38f; int gt_ = 0, ge_ = 0; \
                    for (int m_ = 0; m_ < (nx); ++m_) { const float cm_ = __int_as_float(__builtin_amdgcn_readlane(__float_as_int(c_), m_)); gt_ += (cm_ > c_) ? 1 : 0; ge_ += (cm_ >= c_) ? 1 : 0; } \
                    const unsigned long long hm_ = __ballot(lane < (nx) && gt_ < (kx) && (kx) <= ge_); \
                    if (hm_ != 0ull) { const int L_ = __builtin_ctzll(hm_); thrx = __int_as_float(__builtin_amdgcn_readlane(__float_as_int(c_), L_)); \
                        const int G_ = __builtin_amdgcn_readlane(gt_, L_), E_ = __builtin_amdgcn_readlane(ge_, L_); tiex = (E_ > (kx)); needx = (kx) - G_; donex = true; } } } while (0)
                RANK(r0, n0, k0, 0, thr0, tie0, need0, done0); RANK(r1, n1, k1, 64, thr1, tie1, need1, done1);
#undef RANK
            }
#undef BIN0
#undef BIN1
        }
    }
#define CNT2(x0, x1, c0, c1) do { unsigned c_ = 0u; int sa_ = 0, sb_ = 0; _Pragma("unroll") for (int i_ = 0; i_ < 32; ++i_) { \
            if (i_ & 1) { sa_ += __builtin_popcountll(__ballot(v0[i_] >= (x0))); sb_ += __builtin_popcountll(__ballot(v1[i_] >= (x1))); }     \
            else { c_ += (v0[i_] >= (x0)) ? 1u : 0u; c_ += (v1[i_] >= (x1)) ? 0x10000u : 0u; } }                                                 \
        c_ = wave_sum_u32(c_); c0 = (int)(c_ & 0xffffu) + sa_; c1 = (int)(c_ >> 16) + sb_; } while (0)
    if (!(done0 && done1)) {
        int c0, c1; CNT2(hi0, hi1, c0, c1);
        if (!done0 && c0 >= 256) { thr0 = hi0; tie0 = (c0 > 256); done0 = true; }
        if (!done1 && c1 >= 256) { thr1 = hi1; tie1 = (c1 > 256); done1 = true; }
        for (int it = 0; it < 14 && !(done0 && done1); ++it) {
            const float mid0 = 0.5f * (lo0 + hi0), mid1 = 0.5f * (lo1 + hi1);
            if (!done0 && !(mid0 > lo0 && mid0 < hi0)) { thr0 = lo0; tie0 = true; done0 = true; }
            if (!done1 && !(mid1 > lo1 && mid1 < hi1)) { thr1 = lo1; tie1 = true; done1 = true; }
            if (done0 && done1) break;
            CNT2(mid0, mid1, c0, c1);
            if (!done0) { if (c0 == 256) { thr0 = mid0; done0 = true; } else if (c0 > 256) lo0 = mid0; else hi0 = mid0; }
            if (!done1) { if (c1 == 256) { thr1 = mid1; done1 = true; } else if (c1 > 256) lo1 = mid1; else hi1 = mid1; }
        }
        if (!(done0 && done1)) {
#define F2KEY(f) ({ const unsigned u_ = __float_as_uint(f); (u_ & 0x80000000u) ? ~u_ : (u_ | 0x80000000u); })
#define KEY2F(k) ({ const unsigned k_ = (k); __uint_as_float((k_ & 0x80000000u) ? (k_ & 0x7fffffffu) : ~k_); })
            unsigned kl0 = F2KEY(lo0), kh0 = F2KEY(hi0), kl1 = F2KEY(lo1), kh1 = F2KEY(hi1);
            while (!(done0 && done1)) {
                if (!done0 && kh0 - kl0 <= 1u) { thr0 = KEY2F(kl0); tie0 = true; done0 = true; }
                if (!done1 && kh1 - kl1 <= 1u) { thr1 = KEY2F(kl1); tie1 = true; done1 = true; }
                if (done0 && done1) break;
                const unsigned km0 = kl0 + ((kh0 - kl0) >> 1), km1 = kl1 + ((kh1 - kl1) >> 1);
                const float mid0 = KEY2F(km0), mid1 = KEY2F(km1);
                CNT2(mid0, mid1, c0, c1);
                if (!done0) { if (c0 == 256) { thr0 = mid0; done0 = true; } else if (c0 > 256) kl0 = km0; else kh0 = km0; }
                if (!done1) { if (c1 == 256) { thr1 = mid1; done1 = true; } else if (c1 > 256) kl1 = km1; else kh1 = km1; }
            }
#undef F2KEY
#undef KEY2F
        }
        if ((tie0 && need0 < 0) || (tie1 && need1 < 0)) { unsigned c_ = 0u;
#pragma unroll
            for (int i = 0; i < 32; ++i) { c_ += (v0[i] > thr0) ? 1u : 0u; c_ += (v1[i] > thr1) ? 0x10000u : 0u; }
            c_ = wave_sum_u32(c_); if (need0 < 0) need0 = 256 - (int)(c_ & 0xffffu); if (need1 < 0) need1 = 256 - (int)(c_ >> 16); }
    }
#undef CNT2
    if constexpr (EMIT) { topk_emit(v0, t0, all0, thr0, tie0, need0, bm0, lane);
    topk_emit(v1, t1, all1, thr1, tie1, need1, bm1, lane); } else { if (thr0 + thr1 == 12345.678f && lane == 0) bm0[0] = 0u; }
}
template <int MODE = 0> __device__ __forceinline__ void idx_unit(const bf16* H, unsigned* BM, int b, int q16, LAS unsigned char* ldsL, int tid_in) {
    int tid = tid_in; OPAQUE_V(tid);
    const int lane = tid & 63, wave = __builtin_amdgcn_readfirstlane(tid >> 6), qc = lane & 15, kg = lane >> 4;
    const bf16* hb = H + (size_t)b * SEQ * NH;
    const int t0 = q16 * 16, tq = t0 + qc, nkt = q16 + 1;
    LAS float* SC = (LAS float*)ldsL;
    bf16x8 qf[8]; float wq[8];
#pragma unroll
    for (int hh = 0; hh < 8; ++hh) { qf[hh] = *(const bf16x8*)(hb + (size_t)tq * NH + HC_IDXQ + hh * 32 + kg * 8); wq[hh] = bf2f(hb[(size_t)tq * NH + HC_IDXW + hh]); }
    __syncthreads();
    bf16x8 kfs[16];
#pragma unroll
    for (int i = 0; i < 16; ++i) { const int kt = wave + 8 * i; if (kt < nkt) kfs[i] = *(const bf16x8*)(hb + (size_t)(kt * 16 + qc) * NH + HC_IDXK + kg * 8); }
#pragma unroll
    for (int i = 0; i < 16; ++i) { const int kt = wave + 8 * i;
        if (kt < nkt) {
        const int key0 = kt * 16;
        f32x4 sc = (f32x4){0.f, 0.f, 0.f, 0.f};
#pragma unroll
        for (int hh = 0; hh < 8; ++hh) { const f32x4 d = __builtin_amdgcn_mfma_f32_16x16x32_bf16(kfs[i], qf[hh], (f32x4){0.f, 0.f, 0.f, 0.f}, 0, 0, 0);
            sc[0] += wq[hh] * fmaxf(d[0], 0.f); sc[1] += wq[hh] * fmaxf(d[1], 0.f); sc[2] += wq[hh] * fmaxf(d[2], 0.f); sc[3] += wq[hh] * fmaxf(d[3], 0.f); }
#pragma unroll
        for (int r = 0; r < 4; ++r) if (key0 + 4 * kg + r > tq) sc[r] = -3.0e38f;
        *(LAS f32x4*)(SC + qc * 2048 + key0 + 4 * kg) = sc;
        } }
    __syncthreads();
    const int nk = nkt * 16;
    if constexpr (MODE == 0 || MODE == 2 || MODE == 3) { const int row = wave * 2; float v0[32], v1[32];
#pragma unroll
      for (int i = 0; i < 32; ++i) { const bool ok = (64 * i + lane < nk); v0[i] = ok ? SC[row * 2048 + 64 * i + lane] : -3.0e38f; v1[i] = ok ? SC[(row + 1) * 2048 + 64 * i + lane] : -3.0e38f; }
      topk_rows2<MODE == 0, (MODE == 3 ? 32 : 1000)>(v0, v1, t0 + row, t0 + row + 1, BM + ((size_t)b * SEQ + t0 + row) * 64, BM + ((size_t)b * SEQ + t0 + row + 1) * 64, lane, (LAS unsigned*)(ldsL + RING_BYTES + 1024) + wave * 256, (LAS float*)(ldsL + RING_BYTES + 1024 + 8192) + wave * 128); }
}
__device__ __forceinline__ void compress_unit(PP p, int l, int item, LAS unsigned char* ldsL, int tid_in) {
    int tid = tid_in; OPAQUE_V(tid);
    const int lane = tid & 63, wave = __builtin_amdgcn_readfirstlane(tid >> 6), rr = lane & 15, kq = lane >> 4;
    const int kv = item >> 7, b = (item >> 3) & 15, n0 = (item & 7) * 16;
    const bf16* hb = (const bf16*)(p->ws + WS_BIG) + (size_t)b * SEQ * NH + (kv ? HC_VCMP : HC_KCMP);
    const bf16* w1t = (const bf16*)(p->ws + WS_CW1) + (size_t)(l * 2 + kv) * 64 * 2048;
    f32x4 acc[4];
#pragma unroll
    for (int nt = 0; nt < 4; ++nt) acc[nt] = (f32x4){0.f, 0.f, 0.f, 0.f};
#pragma unroll
    for (int half = 0; half < 2; ++half) {
        bf16x8 af[4], bfr[4][4];
#pragma unroll
        for (int k4 = 0; k4 < 4; ++k4) { const int ks = half * 4 + k4; int tok = 16 * (n0 + rr) + 4 * wave + (ks >> 1); tok = tok > SEQ - 1 ? SEQ - 1 : tok;
            af[k4] = *(const bf16x8*)(hb + (size_t)tok * NH + 32 * (ks & 1) + 8 * kq);
#pragma unroll
            for (int nt = 0; nt < 4; ++nt) bfr[k4][nt] = *(const bf16x8*)(w1t + (size_t)(16 * nt + rr) * 2048 + 256 * wave + 32 * ks + 8 * kq); }
#pragma unroll
        for (int k4 = 0; k4 < 4; ++k4)
#pragma unroll
            for (int nt = 0; nt < 4; ++nt) acc[nt] = __builtin_amdgcn_mfma_f32_16x16x32_bf16(af[k4], bfr[k4][nt], acc[nt], 0, 0, 0);
    }
    LAS float* PS = (LAS float*)ldsL;
    LAS float* HD = (LAS float*)(ldsL + 32768);
    __syncthreads();
#pragma unroll
    for (int nt = 0; nt < 4; ++nt)
#pragma unroll
        for (int r = 0; r < 4; ++r) PS[(wave * 16 + 4 * kq + r) * 64 + 16 * nt + rr] = acc[nt][r];
    __syncthreads();
    const int row = tid >> 5, c0 = 2 * (tid & 31);
    { const float* cb = (const float*)(p->ws + WS_CBIAS) + (l * 2 + kv) * 32 * 64;
#pragma unroll
      for (int e = 0; e < 2; ++e) { float a = 0.f;
#pragma unroll 8
          for (int pp = 0; pp < 32; ++pp) a += cb[pp * 64 + c0 + e];
#pragma unroll
          for (int w = 0; w < 8; ++w) a += PS[(w * 16 + row) * 64 + c0 + e];
          const float u = 0.7978845608028654f * (a + 0.044715f * a * a * a), th = 1.0f - 2.0f / (__expf(2.0f * u) + 1.0f);
          HD[row * 64 + c0 + e] = 0.5f * a * (1.0f + th); } }
    __syncthreads();
    { const float* w2 = p->in[kv ? I_WV2 : I_WK2] + (size_t)l * 64 * 64; float o0 = 0.f, o1 = 0.f;
#pragma unroll 8
      for (int jj = 0; jj < 64; ++jj) { const float hv = HD[row * 64 + jj]; const f32x2 wv = *(const f32x2*)(w2 + jj * 64 + c0); o0 += hv * wv.x; o1 += hv * wv.y; }
      const int n = n0 + row; if (n == 127) { o0 = 0.f; o1 = 0.f; }
      *(unsigned*)((bf16*)(p->ws + WS_KC) + ((size_t)(kv * BATCH + b) * 128 + n) * 64 + c0) = pk2(o0, o1); }
}
__global__ void __launch_bounds__(NTHR, 2) fwd(P p_arg_unused) {
    extern __shared__ __attribute__((aligned(16))) unsigned char lds[];
    LAS unsigned char* ldsL = (LAS unsigned char*)lds;
    const int wave = __builtin_amdgcn_readfirstlane((int)threadIdx.x >> 6);
#define TIDNOW() (wave * 64 + lane_id())
    const int G = gridDim.x, bx = blockIdx.x, vcu = (G % 8 == 0) ? (bx % 8) * (G / 8) + bx / 8 : bx;
    const int gw0 = vcu * NWAVES + wave, NGW = G * NWAVES;
#define FRESH() int lane = lane_id(), gw = gw0; OPAQUE_V(lane); OPAQUE_S(gw); const int tidf = wave * 64 + lane
    for (int u = TIDNOW(); u < (LDS_BYTES - RING_BYTES) / 4; u += NTHR) ((LAS unsigned*)(ldsL + RING_BYTES))[u] = 0u;
    __syncthreads();
#define WSP (getp()->ws)
    XcdBarrier bar = xcd_barrier_post((unsigned*)(getp()->ws + WS_CTL) + CW_BAR, (volatile LAS unsigned*)(ldsL + MISC_OFF) + 8);
#define GRID_BAR() do { XcdBarrier b_ = bar; unsigned x_ = b_.x; unsigned* p_ = b_.bar; asm volatile("" : "+s"(x_), "+s"(p_)); b_.x = x_; b_.bar = p_; xcd_barrier_w(b_, TIDNOW() == 0); } while (0)
    LAS float* wscr = (LAS float*)(ldsL + wave * 16384);
#define XB ((bf16*)(WSP + WS_XB))
#define HB ((bf16*)(WSP + WS_BIG))
#define YC ((bf16*)(WSP + WS_YCAT))
#define OUTP (getp()->out)

    for (int rep = 0; rep < 1 + PROBE_PRO; ++rep) { FRESH(); prologue(getp(), ldsL, gw, NGW, lane, wave); }
    GRID_BAR();

#define GEMM_PHASE(EPI, A_, B_, N_, K_, ...) do { pg8::Gemm g_{(const pg8::bf16_t*)(A_), (const pg8::bf16_t*)(B_), M, (N_), (K_)}; pg8::StaticOrder S_; S_.init(M, (N_), G, bx); \
        pg8::EPI E_{__VA_ARGS__}; pg8::gemm_phase<pg8::EPI, pg8::StaticOrder, true, true>(ldsL, g_, S_, E_, TIDNOW()); } while (0)

#define GEMM_PHASE8(EPI, A_, B_, N_, K_, ...) do { pg8::Gemm g_{(const pg8::bf16_t*)(A_), (const pg8::bf16_t*)(B_), M, (N_), (K_)}; pg8::StaticOrder S_; S_.init(M, (N_), G, bx); \
        pg8::EPI E_{__VA_ARGS__}; pg8::gemm_phase<pg8::EPI, pg8::StaticOrder, true, true, true>(ldsL, g_, S_, E_, TIDNOW()); } while (0)
#define XQ8 (WSP + WS_XQ8)
#define H8 (WSP + WS_BIG)
    for (int l = 0; l < DEPTH; ++l) {
        unsigned char* wl = WSP + WS_W + (size_t)l * W_LAYER;
        for (int rep = 0; rep < 1 + PROBE_UP; ++rep) { GEMM_PHASE8(EpiSwiGLU8, XQ8, wl + WO_13A, 2 * FF, DM / 2, H8, FF, 1.0f / W13_SCALE); }
        GRID_BAR();
        GEMM_PHASE8(EpiResid, H8, wl + WO_2A, DM, FF / 2, XB, DM, DN_ALPHA, 0.5f / W2_SCALE);
        GRID_BAR();
        { FRESH(); ln_phase(XB, nullptr, getp()->in[I_LN1G] + l * DM, getp()->in[I_LN1B] + l * DM, gw, NGW, lane); }
        for (int rep = 0; rep < PROBE_BAR; ++rep) GRID_BAR();
        GRID_BAR();
        for (int rep = 0; rep < PROBE_PREP; ++rep) { GEMM_PHASE(EpiBf16, XB, wl + WO_IN, NH, DM, HB, NH); GRID_BAR(); { FRESH(); const f32x2* T64 = (const f32x2*)(WSP + WS_TAB); const f32x2* T32 = (const f32x2*)(WSP + WS_T32); for (int m = gw; m < M; m += NGW) prep_token(HB + (size_t)m * NH, m % SEQ, T64, T32, lane); } GRID_BAR(); }
        GEMM_PHASE(EpiBf16, XB, wl + WO_IN, NH, DM, HB, NH);
        GRID_BAR();
        { FRESH(); const f32x2* T64 = (const f32x2*)(WSP + WS_TAB); const f32x2* T32 = (const f32x2*)(WSP + WS_T32);
          for (int m = gw; m < M; m += 2 * NGW) { u32x4 ra[6], rb[6]; const int m2 = (m + NGW < M) ? m + NGW : m;
              prep_load(HB + (size_t)m * NH, ra, lane); prep_load(HB + (size_t)m2 * NH, rb, lane);
              prep_row(HB + (size_t)m * NH, ra, m % SEQ, T64, T32, lane);
              if (m2 != m) prep_row(HB + (size_t)m2 * NH, rb, m2 % SEQ, T64, T32, lane); }
        }
        GRID_BAR();
        for (int rep = 0; rep < 1 + PROBE_CMP; ++rep) { FRESH(); for (int it = vcu; it < 2 * BATCH * 8; it += G) compress_unit(getp(), l, it, ldsL, tidf); }
        GRID_BAR();
        for (int repa = 0; repa < 1 + PROBE_ATT + (PROBE_SOLO >= 0 ? 1 : 0); ++repa) {
        { FRESH(); unsigned* qctr = (unsigned*)(WSP + WS_CTL) + CW_QUEUE + l * 128 + repa * 16; volatile LAS int* slot = (volatile LAS int*)(ldsL + MISC_OFF + 64);
          for (;;) {
              __syncthreads();
              if (tidf == 0) *slot = (int)atomicAdd(qctr, 1u);
              __syncthreads();
              const int item = __builtin_amdgcn_readfirstlane(*slot);
              if (item >= ((PROBE_SOLO >= 0 && repa == 1) ? 512 : 2048 + (PROBE_KIND >= 0 ? 512 * PROBE_MULT : 0))) break;
              const int kind = (PROBE_SOLO >= 0 && repa == 1) ? PROBE_SOLO : ((item < 2048) ? (((item >> 9) + 3) & 3) : PROBE_KIND), c = item & 511, jd = 31 - (c >> 4), bd = c & 15;
              if (kind == 0) { const int qb = 7 - c / 64, bh = c % 64; mla_unit(HB, YC, bh >> 2, bh & 3, qb, ldsL, tidf); }
              else if (kind == 1) {
#if FAST_NSA
                  nsa_unit(HB, (const bf16*)(WSP + WS_KC), YC, bd, jd, ldsL, tidf);
#else
                  for (int k = 0; k < 8; ++k) attn_token_naive<4>(getp(), bd * SEQ + jd * 64 + wave * 8 + k, wscr, lane);
#endif
              } else if (kind == 2) {
#if FAST_SB
                  const int qb = 7 - c / 64, bh = c % 64; sb_unit(HB, YC, bh >> 2, bh & 3, qb, ldsL, tidf);
#else
                  for (int k = 0; k < 8; ++k) attn_token_naive<2>(getp(), bd * SEQ + jd * 64 + wave * 8 + k, wscr, lane);
#endif
              } else {
#if FAST_DSA
                  if (PROBE_SOLO == 3 && repa == 1) { for (int k = 3; k >= 0; --k) idx_unit<PROBE_IDXMODE>(HB, (unsigned*)(WSP + WS_BITM), bd, jd * 4 + k, ldsL, tidf); } else
                  { for (int k = 3; k >= 0; --k) idx_unit(HB, (unsigned*)(WSP + WS_BITM), bd, jd * 4 + k, ldsL, tidf);
                    asm volatile("s_waitcnt vmcnt(0)" ::: "memory"); __syncthreads();
                    dsa_unit(HB, (const unsigned*)(WSP + WS_BITM), YC, bd, jd, ldsL, tidf); }
#else
                  for (int k = 0; k < 8; ++k) attn_token_naive<8>(getp(), bd * SEQ + jd * 64 + wave * 8 + k, wscr, lane);
#endif
              }
          } }
        GRID_BAR();
        }
        { FRESH(); gnorm_phase(YC, gw, NGW, lane); }
        GRID_BAR();
        GEMM_PHASE(EpiResid, YC, wl + WO_OUT, DM, DM, XB, DM, DN_ALPHA, 1.0f);
        GRID_BAR();
        { FRESH(); ln_phase(XB, nullptr, getp()->in[I_LN2G] + l * DM, getp()->in[I_LN2B] + l * DM, gw, NGW, lane, XQ8); }
        GRID_BAR();
        GEMM_PHASE8(EpiSwiGLU8, XQ8, wl + WO_13B, 2 * FF, DM / 2, H8, FF, 1.0f / W13_SCALE);
        GRID_BAR();
        GEMM_PHASE8(EpiResid, H8, wl + WO_2B, DM, FF / 2, XB, DM, DN_ALPHA, 0.5f / W2_SCALE);
        GRID_BAR();
        { FRESH(); ln_phase(XB, (l == DEPTH - 1) ? OUTP : nullptr, getp()->in[I_LN3G] + l * DM, getp()->in[I_LN3B] + l * DM, gw, NGW, lane, XQ8); }
        GRID_BAR();
    }
#undef GEMM_PHASE
#undef GEMM_PHASE8
#undef XQ8
#undef H8
#undef TIDNOW
#undef WSP
#undef XB
#undef HB
#undef YC
#undef OUTP
}

extern "C" void kernel_launch(void* const* d_in, const int* in_sizes, int n_in, void* d_out, int out_size, void* d_ws, size_t ws_size, hipStream_t stream) {
    static int grid = 0;
    if (grid == 0) {
        if (n_in != N_IN || in_sizes[0] != M * DM || out_size != M * DM || ws_size < WS_END) { fprintf(stderr, "kernel_launch: unexpected shapes (n_in %d, in0 %d, out %d, ws %zu < %zu); nothing launched\n", n_in, n_in > 0 ? in_sizes[0] : -1, out_size, ws_size, (size_t)WS_END); grid = -1; return; }
        int dev = 0, cus = 0, per_cu = 0;
        if (hipGetDevice(&dev) != hipSuccess || hipDeviceGetAttribute(&cus, hipDeviceAttributeMultiprocessorCount, dev) != hipSuccess) { grid = -1; return; }
        if (hipFuncSetAttribute((const void*)fwd, hipFuncAttributeMaxDynamicSharedMemorySize, LDS_BYTES) != hipSuccess) { fprintf(stderr, "kernel_launch: hipFuncSetAttribute failed\n"); grid = -1; return; }
        if (hipOccupancyMaxActiveBlocksPerMultiprocessor(&per_cu, (const void*)fwd, NTHR, LDS_BYTES) != hipSuccess || per_cu < 1) fprintf(stderr, "kernel_launch: note: occupancy query reports %d\n", per_cu);
        (void)hipGetLastError();
        grid = cus;
    }
    if (grid < 0) return;
    if (hipMemsetAsync((char*)d_ws + WS_CTL, 0, CTL_ZERO_BYTES, stream) != hipSuccess) return;
    P p{};
    for (int i = 0; i < N_IN; ++i) p.in[i] = (const float*)d_in[i];
    p.out = (float*)d_out; p.ws = (unsigned char*)d_ws;
    hipLaunchKernelGGL(fwd, dim3(grid), dim3(NTHR), LDS_BYTES, stream, p);
}
```

```cpp
#include <hip/hip_runtime.h>
#include <cstdio>
#include <cstdint>
namespace pg8 {
#define PG8_LAS __attribute__((address_space(3)))
typedef unsigned short bf16_t;
typedef short bf16x8 __attribute__((ext_vector_type(8)));
typedef float f32x4 __attribute__((ext_vector_type(4)));
typedef unsigned u32x4 __attribute__((ext_vector_type(4)));
typedef int i32x4 __attribute__((ext_vector_type(4)));
constexpr int BM = 256, BK = 64, HALF = 128, HTB = HALF * BK * 2  , STAGE_BYTES = 8 * HTB, NXCD = 8, WGM = 8;

__host__ __device__ __forceinline__ int lds_byte(int r, int c) { const int st = (r >> 4) * 2 + (c >> 5), rr = r & 15, cc = c & 31, ob = rr * 64 + cc * 2; return st * 1024 + (ob ^ (((ob >> 9) & 1) << 5)); }
__host__ __device__ __forceinline__ void stage_rc(int b, int& R, int& C) { const int st = b / 1024, sb = b % 1024, swz = sb ^ (((sb >> 9) & 1) << 5); R = (st >> 1) * 16 + swz / 64; C = (st & 1) * 32 + (swz % 64) / 2; }
__host__ __device__ __forceinline__ int perm32(int rho) { const int n = rho >> 4, i = rho & 15; return 8 * (i >> 2) + 4 * n + (i & 3); }

struct Unit { int pm, pn; };
struct Gemm { const bf16_t* A; const bf16_t* Bt; int M, N, K; };

struct StaticOrder {
    int nM, nN, nwg, G, c;
    __host__ __device__ void init(int M, int N, int G_, int c_) { nM = M / BM; nN = N / BM; nwg = nM * nN; G = G_; c = c_; }
    __host__ __device__ bool next(int i, Unit& u) const {
        const long L = (long)i * G + c; if (L >= nwg) return false;
        int wgid = (int)L; { const int q = nwg / NXCD, r = nwg % NXCD, xcd = wgid % NXCD, off = wgid / NXCD; wgid = (xcd < r ? xcd * (q + 1) : r * (q + 1) + (xcd - r) * q) + off; }
        const int nig = WGM * nN, gid = wgid / nig, fm = gid * WGM, gsz = (nM - fm) < WGM ? (nM - fm) : WGM;
        u.pm = fm + ((wgid % nig) % gsz); u.pn = (wgid % nig) / gsz; return true;
    }
    __device__ __forceinline__ void a_ready(const Unit&) const {}
    __device__ __forceinline__ void done(const Unit&) const {}
};

__device__ __forceinline__ unsigned cvt_pk_bf16(float lo, float hi) { unsigned r; asm volatile("v_cvt_pk_bf16_f32 %0, %1, %2" : "=v"(r) : "v"(lo), "v"(hi)); return r; }
typedef float f32x2 __attribute__((ext_vector_type(2)));
typedef float f32x2 __attribute__((ext_vector_type(2)));
struct EpiBf16 {
    static constexpr bool PERM = true, AFTER_DRAIN = false;
    bf16_t* O; int ldc;
    __device__ __forceinline__ void operator()(const f32x4 (&acc)[2][2][4][2], const Unit& u, int wr, int wc, int fr, int fq) const {
        const int row0 = u.pm * BM + wr * 64 + fr, col0 = u.pn * BM + wc * 32 + 8 * fq;
#pragma unroll
        for (int ai = 0; ai < 2; ++ai)
#pragma unroll
            for (int m = 0; m < 4; ++m) { bf16_t* rowp = O + (size_t)(row0 + ai * HALF + m * 16) * ldc + col0;
#pragma unroll
                for (int bj = 0; bj < 2; ++bj) { const f32x4 v0 = acc[ai][bj][m][0], v1 = acc[ai][bj][m][1];
                    u32x4 w; w.x = cvt_pk_bf16(v0[0], v0[1]); w.y = cvt_pk_bf16(v0[2], v0[3]); w.z = cvt_pk_bf16(v1[0], v1[1]); w.w = cvt_pk_bf16(v1[2], v1[3]);
                    *(u32x4*)(rowp + bj * HALF) = w; } }
    }
};
__device__ __forceinline__ float silu_mul(float g, float u) { return g * __builtin_amdgcn_rcpf(1.0f + __builtin_amdgcn_exp2f(-1.4426950408889634f * g)) * u; }
struct EpiSwiGLU {
    static constexpr bool PERM = true, AFTER_DRAIN = false;
    bf16_t* O; int ldc;
    __device__ __forceinline__ void operator()(const f32x4 (&acc)[2][2][4][2], const Unit& u, int wr, int wc, int fr, int fq) const {
        const int row0 = u.pm * BM + wr * 64 + fr, col0 = u.pn * HALF + wc * 32 + 8 * fq;
#pragma unroll
        for (int ai = 0; ai < 2; ++ai)
#pragma unroll
            for (int m = 0; m < 4; ++m) { bf16_t* rowp = O + (size_t)(row0 + ai * HALF + m * 16) * ldc + col0;
                const f32x4 g0 = acc[ai][0][m][0], g1 = acc[ai][0][m][1], u0 = acc[ai][1][m][0], u1 = acc[ai][1][m][1];
                u32x4 w; w.x = cvt_pk_bf16(silu_mul(g0[0], u0[0]), silu_mul(g0[1], u0[1])); w.y = cvt_pk_bf16(silu_mul(g0[2], u0[2]), silu_mul(g0[3], u0[3]));
                w.z = cvt_pk_bf16(silu_mul(g1[0], u1[0]), silu_mul(g1[1], u1[1])); w.w = cvt_pk_bf16(silu_mul(g1[2], u1[2]), silu_mul(g1[3], u1[3]));
                *(u32x4*)rowp = w; }
    }
};
struct EpiResid {
    static constexpr bool PERM = true, AFTER_DRAIN = false;
    bf16_t* X; int ldc; float alpha, sc;
    __device__ __forceinline__ void operator()(const f32x4 (&acc)[2][2][4][2], const Unit& u, int wr, int wc, int fr, int fq) const {
        const int row0 = u.pm * BM + wr * 64 + fr, col0 = u.pn * BM + wc * 32 + 8 * fq;
        u32x4 xv[2][4][2];
#pragma unroll
        for (int ai = 0; ai < 2; ++ai)
#pragma unroll
            for (int m = 0; m < 4; ++m) { const bf16_t* rowp = X + (size_t)(row0 + ai * HALF + m * 16) * ldc + col0;
#pragma unroll
                for (int bj = 0; bj < 2; ++bj) xv[ai][m][bj] = *(const u32x4*)(rowp + bj * HALF); }
        __builtin_amdgcn_sched_barrier(0);
#pragma unroll
        for (int ai = 0; ai < 2; ++ai)
#pragma unroll
            for (int m = 0; m < 4; ++m) { bf16_t* rowp = X + (size_t)(row0 + ai * HALF + m * 16) * ldc + col0;
#pragma unroll
                for (int bj = 0; bj < 2; ++bj) { const f32x4 v0 = acc[ai][bj][m][0], v1 = acc[ai][bj][m][1]; const u32x4 x = xv[ai][m][bj]; u32x4 w;
                    w.x = cvt_pk_bf16(alpha * __uint_as_float(x.x << 16) + sc * v0[0], alpha * __uint_as_float(x.x & 0xffff0000u) + sc * v0[1]);
                    w.y = cvt_pk_bf16(alpha * __uint_as_float(x.y << 16) + sc * v0[2], alpha * __uint_as_float(x.y & 0xffff0000u) + sc * v0[3]);
                    w.z = cvt_pk_bf16(alpha * __uint_as_float(x.z << 16) + sc * v1[0], alpha * __uint_as_float(x.z & 0xffff0000u) + sc * v1[1]);
                    w.w = cvt_pk_bf16(alpha * __uint_as_float(x.w << 16) + sc * v1[2], alpha * __uint_as_float(x.w & 0xffff0000u) + sc * v1[3]);
                    *(u32x4*)(rowp + bj * HALF) = w; } }
    }
};
struct EpiSwiGLU8 {
    static constexpr bool PERM = true, AFTER_DRAIN = false;
    unsigned char* O; int ldc; float ws;
    __device__ __forceinline__ f32x2 sm2(f32x2 g, f32x2 u, float c1, float c2) const {
        const f32x2 t = g * c1; const f32x2 d = (f32x2){__builtin_amdgcn_exp2f(t[0]), __builtin_amdgcn_exp2f(t[1])} + 1.0f;
        const f32x2 r = (f32x2){__builtin_amdgcn_rcpf(d[0]), __builtin_amdgcn_rcpf(d[1])};
        return (g * r) * (u * c2); }
    __device__ __forceinline__ void operator()(const f32x4 (&acc)[2][2][4][2], const Unit& u, int wr, int wc, int fr, int fq) const {
        const int row0 = u.pm * BM + wr * 64 + fr, col0 = u.pn * HALF + wc * 32 + 8 * fq;
        const float c1 = -1.4426950408889634f * ws, c2 = ws * ws;
#pragma unroll
        for (int ai = 0; ai < 2; ++ai)
#pragma unroll
            for (int m = 0; m < 4; ++m) { unsigned char* rowp = O + (size_t)(row0 + ai * HALF + m * 16) * ldc + col0;
                const f32x4 g0 = acc[ai][0][m][0], g1 = acc[ai][0][m][1], u0 = acc[ai][1][m][0], u1 = acc[ai][1][m][1];
                const f32x2 a0 = sm2((f32x2){g0[0], g0[1]}, (f32x2){u0[0], u0[1]}, c1, c2), a1 = sm2((f32x2){g0[2], g0[3]}, (f32x2){u0[2], u0[3]}, c1, c2);
                const f32x2 b0 = sm2((f32x2){g1[0], g1[1]}, (f32x2){u1[0], u1[1]}, c1, c2), b1 = sm2((f32x2){g1[2], g1[3]}, (f32x2){u1[2], u1[3]}, c1, c2);
                int lo = __builtin_amdgcn_cvt_pk_fp8_f32(a0[0], a0[1], 0, false); lo = __builtin_amdgcn_cvt_pk_fp8_f32(a1[0], a1[1], lo, true);
                int hi = __builtin_amdgcn_cvt_pk_fp8_f32(b0[0], b0[1], 0, false); hi = __builtin_amdgcn_cvt_pk_fp8_f32(b1[0], b1[1], hi, true);
                *(unsigned long long*)rowp = (unsigned long long)(unsigned)lo | ((unsigned long long)(unsigned)hi << 32);
                asm volatile("" ::: "memory"); }
    }
};
template <class Epi, class Sched, bool ALIGN_EPI = false, bool SP2 = false, bool FP8 = false>
__device__ __forceinline__ void gemm_phase(PG8_LAS unsigned char* lds, const Gemm g, const Sched& S, const Epi& E, int tid_in) {
    int tid_ = tid_in; asm volatile("" : "+v"(tid_));
    const int tid = tid_, wid = __builtin_amdgcn_readfirstlane(tid >> 6), lane = tid & 63, wr = wid >> 2, wc = wid & 3, fr = lane & 15, fq = lane >> 4;
    const int K = g.K, nt = K / BK;
    unsigned voffA[2], voffB[2];
#pragma unroll
    for (int i = 0; i < 2; ++i) { int R, C; stage_rc(tid * 16 + i * 8192, R, C); const int Rb = Epi::PERM ? ((R & ~31) + perm32(R & 31)) : R;
        voffA[i] = (unsigned)(R * K + C) * 2u; voffB[i] = (unsigned)(Rb * K + C) * 2u; }
    const size_t kstep = (size_t)(BK * 2);
    const size_t hstep = (size_t)HALF * K * 2;
    const size_t tstep = 2 * hstep;
    const unsigned ldsw = (unsigned)wid * 1024u;
    const int aoff = lds_byte(wr * 64 + fr, fq * 8), boff = lds_byte(wc * 32 + fr, fq * 8);
#define PG8_SA(b, h) (((b) * 2 + (h)) * HTB)
#define PG8_SB(b, h) ((4 + (b) * 2 + (h)) * HTB)
#define PG8_STAGE(bufoff, gbase, voff) do { _Pragma("unroll") for (int _i = 0; _i < 2; ++_i) { \
        if constexpr (FP8) { unsigned keep_;   \
            asm volatile("s_mov_b32 %0, m0\n\ts_mov_b32 m0, %3\n\ts_nop 0\n\tglobal_load_lds_dwordx4 %1, %2\n\ts_mov_b32 m0, %0" : "=&s"(keep_) : "v"((voff)[_i]), "s"((const char*)(gbase)), "s"((unsigned)(uintptr_t)(lds + (bufoff) + ldsw + _i * 8192)) : "memory"); } \
        else __builtin_amdgcn_global_load_lds((const unsigned*)((const char*)(gbase) + (voff)[_i]), (PG8_LAS unsigned*)(lds + (bufoff) + ldsw + _i * 8192), 16, 0, 0); } } while (0)
#define PG8_LDA(dst, b, h) do { _Pragma("unroll") for (int m = 0; m < 4; ++m) _Pragma("unroll") for (int k = 0; k < 2; ++k) dst[m][k] = *(const PG8_LAS bf16x8*)(lds + PG8_SA(b, h) + aoff + m * 2048 + k * 1024); } while (0)
#define PG8_LDB(dst, b, h) do { _Pragma("unroll") for (int n = 0; n < 2; ++n) _Pragma("unroll") for (int k = 0; k < 2; ++k) dst[n][k] = *(const PG8_LAS bf16x8*)(lds + PG8_SB(b, h) + boff + n * 2048 + k * 1024); } while (0)
#define PG8_MMA(ai, bj, At, Bt) do { __builtin_amdgcn_s_setprio(1); \
        if constexpr (FP8) { _Pragma("unroll") for (int m = 0; m < 4; ++m) _Pragma("unroll") for (int n = 0; n < 2; ++n) \
            acc[ai][bj][m][n] = __builtin_amdgcn_mfma_scale_f32_16x16x128_f8f6f4(__builtin_shufflevector(__builtin_bit_cast(i32x4, Bt[n][0]), __builtin_bit_cast(i32x4, Bt[n][1]), 0, 1, 2, 3, 4, 5, 6, 7), \
                __builtin_shufflevector(__builtin_bit_cast(i32x4, At[m][0]), __builtin_bit_cast(i32x4, At[m][1]), 0, 1, 2, 3, 4, 5, 6, 7), acc[ai][bj][m][n], 0, 0, 0, 0x7f7f7f7f, 0, 0x7f7f7f7f); } \
        else { _Pragma("unroll") for (int m = 0; m < 4; ++m) _Pragma("unroll") for (int n = 0; n < 2; ++n) _Pragma("unroll") for (int k = 0; k < 2; ++k) \
            acc[ai][bj][m][n] = __builtin_amdgcn_mfma_f32_16x16x32_bf16(Bt[n][k], At[m][k], acc[ai][bj][m][n], 0, 0, 0); } \
        __builtin_amdgcn_s_setprio(0); } while (0)
#define PG8_WAIT_V(n) asm volatile("s_waitcnt vmcnt(" #n ")" ::: "memory")
#define PG8_WAIT_L(n) asm volatile("s_waitcnt lgkmcnt(" #n ")" ::: "memory")
#define PG8_BAR __builtin_amdgcn_s_barrier()
#define PG8_SCHED __builtin_amdgcn_sched_barrier(0)
    Unit cur, nxt; int ui = 0;
    if (!S.next(0, cur)) return;
    f32x4 acc[2][2][4][2];
#pragma unroll
    for (int a = 0; a < 2; ++a)
#pragma unroll
        for (int b = 0; b < 2; ++b)
#pragma unroll
            for (int m = 0; m < 4; ++m)
#pragma unroll
                for (int n = 0; n < 2; ++n) acc[a][b][m][n] = (f32x4){0.f, 0.f, 0.f, 0.f};
    bf16x8 At[4][2], B0[2][2], B1[2][2];
    const char* cA = (const char*)g.A + (size_t)cur.pm * tstep; const char* cB = (const char*)g.Bt + (size_t)cur.pn * tstep;
    S.a_ready(cur);
    if constexpr (SP2) {
        PG8_STAGE(PG8_SB(0, 0), cB, voffB); PG8_STAGE(PG8_SB(0, 1), cB + hstep, voffB); PG8_STAGE(PG8_SA(0, 0), cA, voffA); PG8_STAGE(PG8_SA(0, 1), cA + hstep, voffA);
        if (wr == 1) PG8_BAR;
        PG8_WAIT_V(2); PG8_BAR;
        PG8_STAGE(PG8_SB(1, 0), cB + kstep, voffB); PG8_STAGE(PG8_SA(1, 0), cA + kstep, voffA); PG8_STAGE(PG8_SB(1, 1), cB + hstep + kstep, voffB);
        PG8_WAIT_V(6); PG8_BAR;
    } else {
        PG8_STAGE(PG8_SB(0, 0), cB, voffB); PG8_STAGE(PG8_SA(0, 0), cA, voffA); PG8_STAGE(PG8_SB(0, 1), cB + hstep, voffB); PG8_STAGE(PG8_SA(0, 1), cA + hstep, voffA);
        if (wr == 1) PG8_BAR;
        PG8_WAIT_V(4); PG8_BAR;
        PG8_STAGE(PG8_SB(1, 0), cB + kstep, voffB); PG8_STAGE(PG8_SA(1, 0), cA + kstep, voffA); PG8_STAGE(PG8_SB(1, 1), cB + hstep + kstep, voffB);
        PG8_WAIT_V(6); PG8_BAR;
    }
    for (;;) {
        const bool has_next = S.next(ui + 1, nxt);
        const char* nA = has_next ? (const char*)g.A + (size_t)nxt.pm * tstep : cA; const char* nB = has_next ? (const char*)g.Bt + (size_t)nxt.pn * tstep : cB;
#pragma unroll 1
        for (int t = 0; t < nt; t += 2) {
            if constexpr (FP8) asm volatile("" : "+v"(voffA[0]), "+v"(voffA[1]), "+v"(voffB[0]), "+v"(voffB[1]));
            const bool last = (t == nt - 2);
            const char* a1 = cA + (size_t)(t + 1) * kstep;
            const char* a2 = last ? nA : cA + (size_t)(t + 2) * kstep; const char* b2 = last ? nB : cB + (size_t)(t + 2) * kstep;
            const char* a3 = a2 + kstep; const char* b3 = b2 + kstep;
            if (last && has_next) S.a_ready(nxt);
            if constexpr (SP2) {
            PG8_LDB(B0, 0, 0); PG8_LDB(B1, 0, 1); PG8_SCHED; PG8_LDA(At, 0, 0); PG8_STAGE(PG8_SA(1, 1), a1 + hstep, voffA);
            PG8_WAIT_V(8); PG8_WAIT_L(0); PG8_BAR; PG8_MMA(0, 0, At, B0); PG8_MMA(0, 1, At, B1); PG8_BAR; PG8_SCHED;
            PG8_LDA(At, 0, 1); PG8_STAGE(PG8_SB(0, 0), b2, voffB); PG8_STAGE(PG8_SB(0, 1), b2 + hstep, voffB); PG8_STAGE(PG8_SA(0, 0), a2, voffA);
            PG8_WAIT_V(8); PG8_WAIT_L(0); PG8_BAR; PG8_MMA(1, 0, At, B0); PG8_MMA(1, 1, At, B1); PG8_BAR; PG8_SCHED;
            PG8_LDB(B0, 1, 0); PG8_LDB(B1, 1, 1); PG8_SCHED; PG8_LDA(At, 1, 0); PG8_STAGE(PG8_SA(0, 1), a2 + hstep, voffA);
            PG8_WAIT_V(8); PG8_WAIT_L(0); PG8_BAR; PG8_MMA(0, 0, At, B0); PG8_MMA(0, 1, At, B1); PG8_BAR; PG8_SCHED;
            PG8_LDA(At, 1, 1); PG8_STAGE(PG8_SB(1, 0), b3, voffB); PG8_STAGE(PG8_SB(1, 1), b3 + hstep, voffB); PG8_STAGE(PG8_SA(1, 0), a3, voffA);
            PG8_WAIT_V(8); PG8_WAIT_L(0); PG8_BAR; PG8_MMA(1, 0, At, B0); PG8_MMA(1, 1, At, B1); PG8_BAR; PG8_SCHED;
            } else {
            PG8_LDB(B0, 0, 0); PG8_SCHED; PG8_LDA(At, 0, 0); PG8_STAGE(PG8_SA(1, 1), a1 + hstep, voffA);
            PG8_WAIT_L(8); PG8_BAR; PG8_WAIT_L(0); PG8_MMA(0, 0, At, B0); PG8_BAR; PG8_SCHED;
            PG8_LDB(B1, 0, 1); PG8_STAGE(PG8_SB(0, 0), b2, voffB);
            PG8_BAR; PG8_WAIT_L(0); PG8_MMA(0, 1, At, B1); PG8_BAR;
            PG8_LDA(At, 0, 1); PG8_STAGE(PG8_SA(0, 0), a2, voffA);
            PG8_BAR; PG8_WAIT_L(0); PG8_MMA(1, 0, At, B0); PG8_BAR; PG8_SCHED;
            PG8_STAGE(PG8_SB(0, 1), b2 + hstep, voffB);
            PG8_WAIT_V(6); PG8_BAR; PG8_MMA(1, 1, At, B1); PG8_BAR;
            PG8_LDB(B0, 1, 0); PG8_SCHED; PG8_LDA(At, 1, 0); PG8_STAGE(PG8_SA(0, 1), a2 + hstep, voffA);
            PG8_WAIT_L(8); PG8_BAR; PG8_WAIT_L(0); PG8_MMA(0, 0, At, B0); PG8_BAR; PG8_SCHED;
            PG8_LDB(B1, 1, 1); PG8_STAGE(PG8_SB(1, 0), b3, voffB);
            PG8_BAR; PG8_WAIT_L(0); PG8_MMA(0, 1, At, B1); PG8_BAR;
            PG8_LDA(At, 1, 1); PG8_STAGE(PG8_SA(1, 0), a3, voffA);
            PG8_BAR; PG8_WAIT_L(0); PG8_MMA(1, 0, At, B0); PG8_BAR; PG8_SCHED;
            PG8_STAGE(PG8_SB(1, 1), b3 + hstep, voffB);
            PG8_WAIT_V(6); PG8_BAR; PG8_MMA(1, 1, At, B1); PG8_BAR;
            }
        }
        if constexpr (ALIGN_EPI) { if (wr == 0) PG8_BAR; }
        if constexpr (!Epi::AFTER_DRAIN) { int ln_; asm volatile("v_mbcnt_lo_u32_b32 %0, -1, 0\n\tv_mbcnt_hi_u32_b32 %0, -1, %0" : "=v"(ln_));
            E(acc, cur, wr, wc, ln_ & 15, ln_ >> 4); S.done(cur); }
        if (!has_next) break;
#pragma unroll
        for (int a = 0; a < 2; ++a)
#pragma unroll
            for (int b = 0; b < 2; ++b)
#pragma unroll
                for (int m = 0; m < 4; ++m)
#pragma unroll
                    for (int n = 0; n < 2; ++n) acc[a][b][m][n] = (f32x4){0.f, 0.f, 0.f, 0.f};
        cur = nxt; cA = nA; cB = nB; ++ui;
        if constexpr (ALIGN_EPI) { if (wr == 1) PG8_BAR; }
    }
    PG8_WAIT_V(0);
    if constexpr (!ALIGN_EPI) { if (wr == 0) PG8_BAR; }
    PG8_BAR;
    if constexpr (Epi::AFTER_DRAIN) { E.fused(acc, cur, wr, wc, fr, fq, lds, wid, lane); S.done(cur); }
#undef PG8_SA
#undef PG8_SB
#undef PG8_STAGE
#undef PG8_LDA
#undef PG8_LDB
#undef PG8_MMA
#undef PG8_WAIT_V
#undef PG8_WAIT_L
#undef PG8_BAR
#undef PG8_SCHED
}
}
#define GAS __attribute__((address_space(1)))
#define LAS __attribute__((address_space(3)))
typedef unsigned short bf16;
typedef unsigned v4u __attribute__((ext_vector_type(4)));
typedef float f32x4 __attribute__((ext_vector_type(4)));
typedef short bf16x8 __attribute__((ext_vector_type(8)));
typedef GAS unsigned gu32;
typedef GAS unsigned long long gu64;
#define RLX_AGENT __ATOMIC_RELAXED, __HIP_MEMORY_SCOPE_AGENT
#define LDS_WAIT() asm volatile("s_waitcnt lgkmcnt(0)" ::: "memory")
#define VM_WAIT() asm volatile("s_waitcnt vmcnt(0)" ::: "memory")
__device__ __forceinline__ unsigned long long rt() { return __builtin_amdgcn_s_memrealtime(); }
__device__ __forceinline__ unsigned f2bf(float f) { unsigned u = __builtin_bit_cast(unsigned, f); return (u + 0x7fffu + ((u >> 16) & 1u)) >> 16; }
__device__ __forceinline__ unsigned pk2(float lo, float hi) { return f2bf(lo) | (f2bf(hi) << 16); }

#define XB_TMO      128
#define XB_XCNT(j)  (256  + 64 * (j))
#define XB_XSUB(j)  (1280 + 64 * (j))
#define XB_XGEN(j)  (2304 + 64 * (j))
#define XB_TOP      3328
#define XB_TOPGEN   3392
#define XCD_BAR_WORDS 3456
#define XB_SPIN_CAP (1u << 18)

__device__ __forceinline__ unsigned xb_ld(unsigned* p)              { return __hip_atomic_load(p, __ATOMIC_RELAXED, __HIP_MEMORY_SCOPE_AGENT); }
__device__ __forceinline__ unsigned xb_add(unsigned* p, unsigned v) { return __hip_atomic_fetch_add(p, v, __ATOMIC_RELAXED, __HIP_MEMORY_SCOPE_AGENT); }
__device__ __forceinline__ unsigned xb_xcc_id() { return (unsigned)__builtin_amdgcn_s_getreg((3 << 11) | 20) & 0xFu; }
#define XB_SPIN(cond, bar) do { unsigned _sp = 0; while (cond) { __builtin_amdgcn_s_sleep(1); \
    if ((++_sp & 255u) == 0u) { if (xb_ld(&(bar)[XB_TMO])) break; if (_sp > XB_SPIN_CAP) { atomicAdd(&(bar)[XB_TMO], 1u); break; } } } } while (0)

struct XcdBarrier {
    unsigned* bar; unsigned x;
    volatile LAS unsigned* st;
};

__device__ __forceinline__ XcdBarrier xcd_barrier_post(unsigned* bar, volatile LAS unsigned* st) {
    XcdBarrier b; b.bar = bar; b.x = xb_xcc_id(); b.st = st;
    if (threadIdx.x == 0) (void)xb_add(&bar[XB_XCNT(b.x)], 1u);
    return b;
}
__device__ __forceinline__ void xcd_barrier_complete(unsigned* bar, unsigned x, unsigned& nloc, unsigned& nx) {
    const unsigned G = gridDim.x * gridDim.y * gridDim.z;
    unsigned sum, cnt, mine, sp = 0u;
    for (;;) {
        sum = 0u; cnt = 0u; mine = 0u;
#pragma unroll
        for (unsigned j = 0; j < 16; ++j) { const unsigned c = xb_ld(&bar[XB_XCNT(j)]); sum += c; cnt += (c > 0u) ? 1u : 0u; mine = (j == x) ? c : mine; }
        if (sum == G) break;
        __builtin_amdgcn_s_sleep(1);
        if ((++sp & 255u) == 0u) { if (xb_ld(&bar[XB_TMO])) break; if (sp > XB_SPIN_CAP) { atomicAdd(&bar[XB_TMO], 1u); break; } }
    }
    nloc = mine > 0u ? mine : 1u; nx = cnt > 0u ? cnt : 1u;
}

__device__ __forceinline__ void xcd_barrier(const XcdBarrier& b) {
    asm volatile("s_waitcnt vmcnt(0)" ::: "memory");
    __syncthreads();
    if (threadIdx.x == 0) {
        unsigned* bar = b.bar;
        __builtin_amdgcn_s_waitcnt(0);
        unsigned nloc = b.st[0], nx = b.st[1];
        if (nloc == 0u) { xcd_barrier_complete(bar, b.x, nloc, nx); b.st[0] = nloc; b.st[1] = nx; }
        const unsigned old = xb_add(&bar[XB_XSUB(b.x)], 1u);
        const unsigned gen = old / nloc;
        if (old + 1u == (gen + 1u) * nloc) {
            __builtin_amdgcn_fence(__ATOMIC_RELEASE, "agent");
            asm volatile("s_waitcnt vmcnt(0)" ::: "memory");
            const unsigned og = xb_add(&bar[XB_TOP], 1u);
            const unsigned tg = og / nx;
            if (og + 1u == (tg + 1u) * nx) xb_add(&bar[XB_TOPGEN], 1u);
            else XB_SPIN(xb_ld(&bar[XB_TOPGEN]) == tg, bar);
            __builtin_amdgcn_fence(__ATOMIC_ACQUIRE, "agent");
            xb_add(&bar[XB_XGEN(b.x)], 1u);
            asm volatile("s_waitcnt vmcnt(0)" ::: "memory");
        } else {
            XB_SPIN(xb_ld(&bar[XB_XGEN(b.x)]) == gen, bar);
            __builtin_amdgcn_fence(__ATOMIC_ACQUIRE, "agent");
            asm volatile("s_waitcnt vmcnt(0)" ::: "memory");
        }
    }
    __syncthreads();
}
__device__ __forceinline__ void xcd_barrier_w(const XcdBarrier& b, bool is_t0) {
    asm volatile("s_waitcnt vmcnt(0)" ::: "memory");
    __syncthreads();
    if (is_t0) {
        unsigned* bar = b.bar;
        __builtin_amdgcn_s_waitcnt(0);
        unsigned nloc = b.st[0], nx = b.st[1];
        if (nloc == 0u) { xcd_barrier_complete(bar, b.x, nloc, nx); b.st[0] = nloc; b.st[1] = nx; }
        const unsigned old = xb_add(&bar[XB_XSUB(b.x)], 1u);
        const unsigned gen = old / nloc;
        if (old + 1u == (gen + 1u) * nloc) {
            __builtin_amdgcn_fence(__ATOMIC_RELEASE, "agent");
            asm volatile("s_waitcnt vmcnt(0)" ::: "memory");
            const unsigned og = xb_add(&bar[XB_TOP], 1u);
            const unsigned tg = og / nx;
            if (og + 1u == (tg + 1u) * nx) xb_add(&bar[XB_TOPGEN], 1u);
            else XB_SPIN(xb_ld(&bar[XB_TOPGEN]) == tg, bar);
            __builtin_amdgcn_fence(__ATOMIC_ACQUIRE, "agent");
            xb_add(&bar[XB_XGEN(b.x)], 1u);
            asm volatile("s_waitcnt vmcnt(0)" ::: "memory");
        } else {
            XB_SPIN(xb_ld(&bar[XB_XGEN(b.x)]) == gen, bar);
            __builtin_amdgcn_fence(__ATOMIC_ACQUIRE, "agent");
            asm volatile("s_waitcnt vmcnt(0)" ::: "memory");
        }
    }
    __syncthreads();
}
#define PROBE_KIND -1
#define PROBE_MULT 4
#define PROBE_B2 0
#define PROBE_PRO 0
#define PROBE_UP 0
#define PROBE_CMP 0
#define PROBE_PREP 0
#define PROBE_LN 0
#define PROBE_BAR 0
#define PROBE_GN 0
#define PROBE_DOWN 0
#define PROBE_ATT 0
#define PROBE_SOLO -1
#define PROBE_IDXMODE 0
#ifndef FAST_NSA
#define FAST_NSA 1
#endif
#ifndef FAST_SB
#define FAST_SB 1
#endif
#ifndef FAST_DSA
#define FAST_DSA 1
#endif
constexpr int NWAVES = 8, NTHR = 512;
constexpr int BATCH = 16, SEQ = 2048, DM = 1024, FF = 2816, M = BATCH * SEQ, DEPTH = 2;
constexpr int NH = 3584;
constexpr int DIN = 2516;
constexpr int HC_CQ = 0, HC_CKV = 256, HC_KROPE = 384, HC_GATE = 416, HC_IDXW = 428, HC_IDXK = 448, HC_QEFF = 512, HC_KVEFF = 896,
              HC_NSAQ = 1408, HC_KCMP = 1664, HC_VCMP = 1728, HC_KSLC = 1792, HC_VSLC = 1856, HC_KWIN = 1920, HC_VWIN = 1984,
              HC_DSAQ = 2048, HC_DSAK = 2304, HC_DSAV = 2368, HC_IDXQ = 2432, HC_SBQ = 2688, HC_SBK = 2944, HC_SBV = 3200;
constexpr int SC_CQ = 0, SC_CKV = 256, SC_KROPE = 384, SC_NSAQ = 416, SC_KCMP = 672, SC_GATE = 1056, SC_DSAQ = 1068, SC_DSAK = 1324,
              SC_IDXQ = 1452, SC_IDXK = 1708, SC_IDXW = 1740, SC_SBQ = 1748;
constexpr float LN_EPS = 1e-5f, RMS_EPS = 1e-6f;
constexpr float DN_ALPHA = 1.4142135623730951f;
constexpr float LOG2E = 1.4426950408889634f;
constexpr float QSC_MLA = 0.10206207261596577f * LOG2E;
constexpr float QSC_64 = 0.125f * LOG2E;
constexpr float W13_SCALE = 128.f, W2_SCALE = 512.f, WOUT_SCALE = 128.f;
enum { I_X = 0, I_LN1G, I_LN1B, I_F1W1, I_F1W3, I_F1W2, I_WIN, I_QNORM, I_WUQ, I_KVNORM, I_WUKV, I_CMPPOS, I_WK1, I_WK2, I_WV1, I_WV2, I_GNG, I_WOUT,
       I_LN2G, I_LN2B, I_F2W1, I_F2W3, I_F2W2, I_LN3G, I_LN3B, N_IN };
constexpr size_t MiB = 1u << 20;
constexpr size_t WS_CTL = 0, CTL_ZERO_BYTES = 64 * 1024;
constexpr size_t WS_TAB = 1 * MiB;
constexpr size_t WS_T32 = WS_TAB + 512 * 1024, WS_CBIAS = WS_TAB + 768 * 1024;
constexpr size_t WS_KC = 2 * MiB;
constexpr size_t WS_SUMSQ = 3 * MiB;
constexpr size_t WS_BITM = 5 * MiB;
constexpr size_t WS_CW1 = 13 * MiB;
constexpr size_t WS_W = 16 * MiB, W_LAYER = 42 * MiB;
constexpr size_t WO_13A = 0, WO_2A = 11 * MiB, WO_13B = 11 * MiB + 5632 * 1024, WO_2B = 27 * MiB + 512 * 1024, WO_IN = 33 * MiB, WO_OUT = 40 * MiB;
constexpr size_t WS_XB = 104 * MiB;
constexpr size_t WS_YCAT = 168 * MiB;
constexpr size_t WS_BIG = 232 * MiB;
constexpr size_t WS_END = 456 * MiB;
constexpr size_t WS_XQ8 = WS_BIG + 128 * MiB;
static_assert(WO_2A == (size_t)5632 * 1024 * 2 && WO_13B == WO_2A + (size_t)1024 * 2816 * 2 && WO_2B == WO_13B + WO_2A && WO_IN == WO_2B + (size_t)1024 * 2816 * 2 && WO_OUT == WO_IN + (size_t)NH * 1024 * 2 && W_LAYER == WO_OUT + 2 * MiB, "weights map");
static_assert(WS_W + 2 * W_LAYER <= WS_XB && WS_XB + (size_t)M * DM * 2 == WS_YCAT && WS_YCAT + (size_t)M * DM * 2 == WS_BIG && WS_BIG + (size_t)M * NH * 2 == WS_END, "ws map");
constexpr int CW_BAR = 1024, CW_QUEUE = 8192;
constexpr int RING_BYTES = 131072, MISC_OFF = RING_BYTES + 320, LDS_BYTES = 147456;
#undef XB_SPIN_CAP
#define XB_SPIN_CAP (1u << 23)
typedef float f32x16 __attribute__((ext_vector_type(16)));
typedef float f32x2 __attribute__((ext_vector_type(2)));
typedef unsigned u32x4 __attribute__((ext_vector_type(4)));
__device__ __forceinline__ float bf2f(unsigned short u) { return __uint_as_float((unsigned)u << 16); }
__device__ __forceinline__ float bflo(unsigned u) { return __uint_as_float(u << 16); }
__device__ __forceinline__ float bfhi(unsigned u) { return __uint_as_float(u & 0xffff0000u); }
template <int K> __device__ __forceinline__ int sx_i(int v) { static_assert(K >= 1 && K < 32, "swizzle xor"); return __builtin_amdgcn_ds_swizzle(v, (K << 10) | 0x1f); }
template <int K> __device__ __forceinline__ float sx_f(float v) { return __int_as_float(sx_i<K>(__float_as_int(v))); }
__device__ __forceinline__ float x32_sum(float v) { auto rr = __builtin_amdgcn_permlane32_swap(__float_as_uint(v), __float_as_uint(v), false, false); return __uint_as_float(rr[0]) + __uint_as_float(rr[1]); }
__device__ __forceinline__ float x32_max(float v) { auto rr = __builtin_amdgcn_permlane32_swap(__float_as_uint(v), __float_as_uint(v), false, false); return fmaxf(__uint_as_float(rr[0]), __uint_as_float(rr[1])); }
__device__ __forceinline__ float x32_min(float v) { auto rr = __builtin_amdgcn_permlane32_swap(__float_as_uint(v), __float_as_uint(v), false, false); return fminf(__uint_as_float(rr[0]), __uint_as_float(rr[1])); }
__device__ __forceinline__ unsigned x32_other_u(unsigned v, int hi) { auto rr = __builtin_amdgcn_permlane32_swap(v, v, false, false); return hi ? rr[0] : rr[1]; }
__device__ __forceinline__ float x32_other(float v, int hi) { return __uint_as_float(x32_other_u(__float_as_uint(v), hi)); }
#define DPP_I(old, x, ctrl, rmask) __builtin_amdgcn_update_dpp((old), (x), (ctrl), (rmask), 0xf, false)
#define DPP_F(old, x, ctrl, rmask) __int_as_float(__builtin_amdgcn_update_dpp(__float_as_int(old), __float_as_int(x), (ctrl), (rmask), 0xf, false))
__device__ __forceinline__ float dpp_scan_sum(float v) { v += DPP_F(0.f, v, 0x111, 0xf); v += DPP_F(0.f, v, 0x112, 0xf); v += DPP_F(0.f, v, 0x114, 0xf); v += DPP_F(0.f, v, 0x118, 0xf); v += DPP_F(0.f, v, 0x142, 0xa); return v; }
__device__ __forceinline__ float dpp_scan_max(float v) { v = fmaxf(v, DPP_F(v, v, 0x111, 0xf)); v = fmaxf(v, DPP_F(v, v, 0x112, 0xf)); v = fmaxf(v, DPP_F(v, v, 0x114, 0xf)); v = fmaxf(v, DPP_F(v, v, 0x118, 0xf)); v = fmaxf(v, DPP_F(v, v, 0x142, 0xa)); return v; }
__device__ __forceinline__ float dpp_scan_min(float v) { v = fminf(v, DPP_F(v, v, 0x111, 0xf)); v = fminf(v, DPP_F(v, v, 0x112, 0xf)); v = fminf(v, DPP_F(v, v, 0x114, 0xf)); v = fminf(v, DPP_F(v, v, 0x118, 0xf)); v = fminf(v, DPP_F(v, v, 0x142, 0xa)); return v; }
__device__ __forceinline__ float rl_f(float v, int l) { return __int_as_float(__builtin_amdgcn_readlane(__float_as_int(v), l)); }
__device__ __forceinline__ float wave_sum(float v) { v = dpp_scan_sum(v); return rl_f(v, 31) + rl_f(v, 63); }
__device__ __forceinline__ float wave_max(float v) { v = dpp_scan_max(v); return fmaxf(rl_f(v, 31), rl_f(v, 63)); }
__device__ __forceinline__ float wave_min(float v) { v = dpp_scan_min(v); return fminf(rl_f(v, 31), rl_f(v, 63)); }
__device__ __forceinline__ float half_sum(float v, int hi) { v = dpp_scan_sum(v); const float a = rl_f(v, 31), b = rl_f(v, 63); return hi ? b : a; }
__device__ __forceinline__ float half_max(float v, int hi) { v = dpp_scan_max(v); const float a = rl_f(v, 31), b = rl_f(v, 63); return hi ? b : a; }
__device__ __forceinline__ float ex2(float x) { return __builtin_amdgcn_exp2f(x); }
__device__ __forceinline__ int lane_id() { int l; asm volatile("v_mbcnt_lo_u32_b32 %0, -1, 0\n\tv_mbcnt_hi_u32_b32 %0, -1, %0" : "=v"(l)); return l; }

template <class F> __device__ __forceinline__ void transpose_item(const F& val, int K, bf16* WT, LAS float* scr, int kb, int nb, int lane) {
    const int k0 = 64 * kb, n0 = 32 * nb;
    float tmp[32];
#pragma unroll
    for (int i = 0; i < 32; ++i) tmp[i] = val(k0 + 2 * i + (lane >> 5), n0 + (lane & 31));
#pragma unroll
    for (int i = 0; i < 32; ++i) scr[(2 * i + (lane >> 5)) * 33 + (lane & 31)] = tmp[i];
    LDS_WAIT(); asm volatile("" ::: "memory");
    const int c = lane & 7;
#pragma unroll
    for (int j = 0; j < 4; ++j) { const int n = (lane >> 3) + 8 * j; const LAS float* s = scr + (8 * c) * 33 + n;
        v4u o; o.x = pk2(s[0 * 33], s[1 * 33]); o.y = pk2(s[2 * 33], s[3 * 33]); o.z = pk2(s[4 * 33], s[5 * 33]); o.w = pk2(s[6 * 33], s[7 * 33]);
        *(GAS v4u*)(WT + (size_t)(n0 + n) * K + k0 + 8 * c) = o; }
    LDS_WAIT(); asm volatile("" ::: "memory");
}
template <class F> __device__ __forceinline__ void transpose_item8(const F& val, int K, unsigned char* WT8, LAS float* scr, int kb, int nb, int lane, float scale) {
    const int k0 = 64 * kb, n0 = 32 * nb;
    float tmp[32];
#pragma unroll
    for (int i = 0; i < 32; ++i) tmp[i] = val(k0 + 2 * i + (lane >> 5), n0 + (lane & 31));
#pragma unroll
    for (int i = 0; i < 32; ++i) scr[(2 * i + (lane >> 5)) * 33 + (lane & 31)] = tmp[i] * scale;
    LDS_WAIT(); asm volatile("" ::: "memory");
    const int c = lane & 7;
#pragma unroll
    for (int j = 0; j < 4; ++j) { const int n = (lane >> 3) + 8 * j; const LAS float* sp = scr + (8 * c) * 33 + n;
        int lo = __builtin_amdgcn_cvt_pk_fp8_f32(sp[0 * 33], sp[1 * 33], 0, false); lo = __builtin_amdgcn_cvt_pk_fp8_f32(sp[2 * 33], sp[3 * 33], lo, true);
        int hi = __builtin_amdgcn_cvt_pk_fp8_f32(sp[4 * 33], sp[5 * 33], 0, false); hi = __builtin_amdgcn_cvt_pk_fp8_f32(sp[6 * 33], sp[7 * 33], hi, true);
        *(GAS unsigned long long*)(WT8 + (size_t)(n0 + n) * K + k0 + 8 * c) = (unsigned long long)(unsigned)lo | ((unsigned long long)(unsigned)hi << 32); }
    LDS_WAIT(); asm volatile("" ::: "memory");
}
struct ValW13 { const float* w1; const float* w3;
    __device__ __forceinline__ float operator()(int k, int n) const { const int col = (n >> 8) * 128 + (n & 127); const uintptr_t d = (n & 128) ? ((uintptr_t)w3 - (uintptr_t)w1) : (uintptr_t)0; return ((const float*)((uintptr_t)w1 + d))[(size_t)k * FF + col]; } };
struct ValPlain { const float* w; int ld;
    __device__ __forceinline__ float operator()(int k, int n) const { return w[(size_t)k * ld + n]; } };
struct ValWout { const float* w; const float* g;
    __device__ __forceinline__ float operator()(int k, int n) const { return w[(size_t)k * DM + n] * g[k]; } };
__device__ __forceinline__ int win_src(int n) {
    if (n < 416) return n;
    if (n < 428) return SC_GATE + (n - 416);
    if (n < 436) return SC_IDXW + (n - 428);
    if (n < 448) return -1;
    if (n < 480) return SC_IDXK + (n - 448);
    if (n < 1408) return -1;
    if (n < 1664) return SC_NSAQ + (n - 1408);
    if (n < 2048) return SC_KCMP + (n - 1664);
    if (n < 2304) return SC_DSAQ + (n - 2048);
    if (n < 2432) return SC_DSAK + (n - 2304);
    if (n < 2688) return SC_IDXQ + (n - 2432);
    if (n < 3456) return SC_SBQ + (n - 2688);
    return -1;
}
struct ValWin { const float* win;
    __device__ __forceinline__ float operator()(int k, int n) const { const int s = win_src(n); const float sc = (n >= HC_SBQ && n < HC_SBQ + 256) ? 0.125f : 1.0f;
        return s < 0 ? 0.f : win[(size_t)k * DIN + s] * sc; } };
__device__ __forceinline__ void merged_tile(const float* win, int src0, int nj, const float* g, const float* wu, int ldu, int c0, int k0, bf16* WTrow0  , int lane) {
    const int i = lane & 31, kk = lane >> 5;
    const float* ap = win + (size_t)(k0 + i) * DIN + src0 + kk;
    const float* bp = wu + (size_t)kk * ldu + c0 + i;
    const float* gp = g + kk;
    f32x16 acc = (f32x16){};
    float a0[16], b0[16], g0[16], a1[16], b1[16], g1[16];
#define MT_LOAD(A_, B_, G_, j_) _Pragma("unroll") for (int u = 0; u < 16; ++u) { A_[u] = ap[(j_) + 2 * u]; B_[u] = bp[(size_t)((j_) + 2 * u) * ldu]; G_[u] = gp[(j_) + 2 * u]; }
#define MT_MMA(A_, B_, G_) _Pragma("unroll") for (int u = 0; u < 16; ++u) acc = __builtin_amdgcn_mfma_f32_32x32x2f32(A_[u], B_[u] * G_[u], acc, 0, 0, 0);
    MT_LOAD(a0, b0, g0, 0);
    for (int j = 0; j < nj; j += 64) {
        MT_LOAD(a1, b1, g1, j + 32);
        MT_MMA(a0, b0, g0);
        if (j + 64 < nj) { MT_LOAD(a0, b0, g0, j + 64); }
        MT_MMA(a1, b1, g1);
    }
#undef MT_LOAD
#undef MT_MMA
    bf16* wrow = WTrow0 + (size_t)i * DM + k0 + 4 * kk;
#pragma unroll
    for (int g4 = 0; g4 < 4; ++g4) *(unsigned long long*)(wrow + 8 * g4) = (unsigned long long)pk2(acc[4 * g4], acc[4 * g4 + 1]) | ((unsigned long long)pk2(acc[4 * g4 + 2], acc[4 * g4 + 3]) << 32);
}
__device__ __forceinline__ f32x2 rope_cs(int t, int i2  ) {
    double inv = 1.0; const double r = 0.7498942093324559;
    for (int q = 0; q < i2; ++q) inv *= r;
    const float ang = (float)t * (float)inv;
    const double a = (double)ang, n = __builtin_rint(a * 0.15915494309189535);
    const double rr = __builtin_fma(-n, 6.283185307179586, a);
    const float rev = (float)(rr * 0.15915494309189535);
    return (f32x2){__builtin_amdgcn_cosf(rev), __builtin_amdgcn_sinf(rev)};
}
struct P { const float* in[N_IN]; float* out; unsigned char* ws; };
#define OPAQUE_V(x) asm volatile("" : "+v"(x))
#define OPAQUE_S(x) asm volatile("" : "+s"(x))
typedef const __attribute__((address_space(4))) P* PP;
__device__ __forceinline__ PP getp() { PP q = (PP)__builtin_amdgcn_kernarg_segment_ptr(); asm volatile("" : "+s"(q)); return q; }

__device__ __forceinline__ void prologue(PP p, LAS unsigned char* ldsL, int gw, int NGW, int lane, int wave) {
    LAS float* scr = (LAS float*)(ldsL + wave * 16384);
    unsigned char* ws = p->ws;
    constexpr int IT_IN = (DM / 64) * (NH / 32), IT_13 = (DM / 64) * (2 * FF / 32), IT_2 = (FF / 64) * (DM / 32), IT_O = (DM / 64) * (DM / 32);
    constexpr int PER_L = IT_IN + 2 * IT_13 + 2 * IT_2 + IT_O;
    for (int it = gw; it < DEPTH * PER_L; it += NGW) {
        const int l = it / PER_L; int r = it % PER_L;
        unsigned char* wl = ws + WS_W + (size_t)l * W_LAYER;
        if (r < IT_IN) { const int nb = r / (DM / 64); if (nb < HC_QEFF / 32 || nb >= HC_NSAQ / 32) { ValWin v{p->in[I_WIN] + (size_t)l * DM * DIN}; transpose_item(v, DM, (bf16*)(wl + WO_IN), scr, r % (DM / 64), nb, lane); } continue; } r -= IT_IN;
        if (r < IT_13) { ValW13 v{p->in[I_F1W1] + (size_t)l * DM * FF, p->in[I_F1W3] + (size_t)l * DM * FF}; transpose_item8(v, DM, wl + WO_13A, scr, r % (DM / 64), r / (DM / 64), lane, W13_SCALE); continue; } r -= IT_13;
        if (r < IT_13) { ValW13 v{p->in[I_F2W1] + (size_t)l * DM * FF, p->in[I_F2W3] + (size_t)l * DM * FF}; transpose_item8(v, DM, wl + WO_13B, scr, r % (DM / 64), r / (DM / 64), lane, W13_SCALE); continue; } r -= IT_13;
        if (r < IT_2) { ValPlain v{p->in[I_F1W2] + (size_t)l * FF * DM, DM}; transpose_item8(v, FF, wl + WO_2A, scr, r % (FF / 64), r / (FF / 64), lane, W2_SCALE); continue; } r -= IT_2;
        if (r < IT_2) { ValPlain v{p->in[I_F2W2] + (size_t)l * FF * DM, DM}; transpose_item8(v, FF, wl + WO_2B, scr, r % (FF / 64), r / (FF / 64), lane, W2_SCALE); continue; } r -= IT_2;
        { ValWout v{p->in[I_WOUT] + (size_t)l * DM * DM, p->in[I_GNG] + l * DM}; transpose_item8(v, DM, wl + WO_OUT, scr, r % (DM / 64), r / (DM / 64), lane, WOUT_SCALE); }
    }
    for (int it = gw; it < DEPTH * 32 * 28; it += NGW) { const int l = it / (32 * 28), r = it % (32 * 28), kb = r % 32, cb = r / 32;
        const float* win = p->in[I_WIN] + (size_t)l * DM * DIN; bf16* WT = (bf16*)(ws + WS_W + (size_t)l * W_LAYER + WO_IN);
        if (cb < 12) merged_tile(win, SC_CQ, 256, p->in[I_QNORM] + l * 256, p->in[I_WUQ] + (size_t)l * 256 * 384, 384, cb * 32, kb * 32, WT + (size_t)(HC_QEFF + cb * 32) * DM, lane);
        else merged_tile(win, SC_CKV, 128, p->in[I_KVNORM] + l * 128, p->in[I_WUKV] + (size_t)l * 128 * 512, 512, (cb - 12) * 32, kb * 32, WT + (size_t)(HC_KVEFF + (cb - 12) * 32) * DM, lane); }
    for (int it = (gw + 4 * 64) % NGW; it < 4 * 64; it += NGW) {   const int mi = it >> 6, r = it & 63; ValPlain v{p->in[(mi & 1) ? I_WV1 : I_WK1] + (size_t)(mi >> 1) * 2048 * 64, 64};
        transpose_item(v, 2048, (bf16*)(ws + WS_CW1) + (size_t)mi * 64 * 2048, scr, r & 31, r >> 5, lane); }
    { f32x2* T64 = (f32x2*)(ws + WS_TAB); f32x2* T32 = (f32x2*)(ws + WS_T32);
      for (int e = gw * 64 + lane; e < SEQ * 32; e += NGW * 64) T64[e] = rope_cs(e >> 5, e & 31);
      for (int e = gw * 64 + lane; e < SEQ * 16; e += NGW * 64) T32[e] = rope_cs(e >> 4, 2 * (e & 15)); }
    if (const int cg = (gw + NGW / 2) % NGW; cg < 128) {   const int mi = cg >> 5, part = cg & 31, l = mi >> 1, kv = mi & 1; const float* pos = p->in[I_CMPPOS] + (size_t)l * 2048 + part * 64; const float* w1 = p->in[kv ? I_WV1 : I_WK1] + (size_t)l * 2048 * 64 + (size_t)part * 64 * 64;
        float a = 0.f;
#pragma unroll 16
        for (int r = 0; r < 64; ++r) a += pos[r] * w1[r * 64 + lane];
        ((float*)(ws + WS_CBIAS))[(mi * 32 + part) * 64 + lane] = a; }
    { const f32x4* x4 = (const f32x4*)p->in[I_X]; unsigned long long* o8 = (unsigned long long*)(ws + WS_XB);
      unsigned* q4 = (unsigned*)(ws + WS_XQ8);
      constexpr int UX = 8; const size_t stride = (size_t)NGW * 64, total = (size_t)M * DM / 4;
      for (size_t e0 = (size_t)gw * 64 + lane; e0 < total; e0 += UX * stride) { f32x4 v[UX];
#pragma unroll
          for (int u = 0; u < UX; ++u) { const size_t e = e0 + u * stride; v[u] = x4[e < total ? e : e0]; }
#pragma unroll
          for (int u = 0; u < UX; ++u) { const size_t e = e0 + u * stride; if (e < total) { o8[e] = (unsigned long long)pk2(v[u].x, v[u].y) | ((unsigned long long)pk2(v[u].z, v[u].w) << 32);
              int q = __builtin_amdgcn_cvt_pk_fp8_f32(v[u].x, v[u].y, 0, false); q = __builtin_amdgcn_cvt_pk_fp8_f32(v[u].z, v[u].w, q, true); q4[e] = (unsigned)q; } } } }
}

__device__ __forceinline__ void ln_phase(bf16* xb, float* fout, const float* g, const float* b, int gw, int NGW, int lane, unsigned char* xq8 = nullptr) {
    constexpr int U = 4;
    f32x4 gg[4], bb[4];
#pragma unroll
    for (int j = 0; j < 4; ++j) { const int c = (j >> 1) * 512 + 8 * lane + (j & 1) * 4; gg[j] = *(const f32x4*)(g + c); bb[j] = *(const f32x4*)(b + c); }
    for (int m0 = gw; m0 < M; m0 += U * NGW) {
        u32x4 raw[U][2];
#pragma unroll
        for (int u = 0; u < U; ++u) { const int m = (m0 + u * NGW < M) ? m0 + u * NGW : m0; const u32x4* xr = (const u32x4*)(xb + (size_t)m * DM) + lane; raw[u][0] = xr[0]; raw[u][1] = xr[64]; }
#pragma unroll
        for (int u = 0; u < U; ++u) { const int m = m0 + u * NGW; if (m >= M) break;
            float v[16];
#pragma unroll
            for (int h = 0; h < 2; ++h)
#pragma unroll
                for (int k = 0; k < 4; ++k) { v[h * 8 + 2 * k] = bflo(raw[u][h][k]); v[h * 8 + 2 * k + 1] = bfhi(raw[u][h][k]); }
            float s = 0.f;
#pragma unroll
            for (int k = 0; k < 16; ++k) s += v[k];
            const float mean = wave_sum(s) * (1.f / DM); float s2 = 0.f;
#pragma unroll
            for (int k = 0; k < 16; ++k) { v[k] -= mean; s2 += v[k] * v[k]; }
            const float rstd = 1.f / sqrtf(wave_sum(s2) * (1.f / DM) + LN_EPS);
#pragma unroll
            for (int k = 0; k < 16; ++k) v[k] = v[k] * rstd * gg[k >> 2][k & 3] + bb[k >> 2][k & 3];
            u32x4* xw = (u32x4*)(xb + (size_t)m * DM) + lane;
            if (!fout) {
#pragma unroll
            for (int h = 0; h < 2; ++h) { u32x4 w; w.x = pk2(v[h * 8], v[h * 8 + 1]); w.y = pk2(v[h * 8 + 2], v[h * 8 + 3]); w.z = pk2(v[h * 8 + 4], v[h * 8 + 5]); w.w = pk2(v[h * 8 + 6], v[h * 8 + 7]); xw[64 * h] = w; }
            }
            if (xq8 && !fout) { unsigned long long* qw = (unsigned long long*)(xq8 + (size_t)m * DM) + lane;
#pragma unroll
                for (int h = 0; h < 2; ++h) { int lo = __builtin_amdgcn_cvt_pk_fp8_f32(v[h * 8], v[h * 8 + 1], 0, false); lo = __builtin_amdgcn_cvt_pk_fp8_f32(v[h * 8 + 2], v[h * 8 + 3], lo, true);
                    int hi = __builtin_amdgcn_cvt_pk_fp8_f32(v[h * 8 + 4], v[h * 8 + 5], 0, false); hi = __builtin_amdgcn_cvt_pk_fp8_f32(v[h * 8 + 6], v[h * 8 + 7], hi, true);
                    qw[64 * h] = (unsigned long long)(unsigned)lo | ((unsigned long long)(unsigned)hi << 32); } }
            if (fout) { f32x4* fo = (f32x4*)(fout + (size_t)m * DM + 8 * lane);
#pragma unroll
                for (int h = 0; h < 2; ++h) { fo[128 * h] = (f32x4){v[h * 8], v[h * 8 + 1], v[h * 8 + 2], v[h * 8 + 3]}; fo[128 * h + 1] = (f32x4){v[h * 8 + 4], v[h * 8 + 5], v[h * 8 + 6], v[h * 8 + 7]}; } }
        }
    }
}
__device__ __forceinline__ void rope_inplace(bf16* hr, int c0, int nh, int half, const f32x2* trow, float f, int lane) {
    for (int pi = lane; pi < nh * half; pi += 64) { const int hd = pi / half, i = pi % half; bf16* q = hr + c0 + hd * 2 * half + i;
        const float z1 = bf2f(q[0]), z2 = bf2f(q[half]); const f32x2 cs = trow[i];
        q[0] = (bf16)f2bf((z1 * cs.x - z2 * cs.y) * f); q[half] = (bf16)f2bf((z1 * cs.y + z2 * cs.x) * f); }
}
__device__ __forceinline__ void scale_inplace(bf16* hr, int c0, int n, float f, int lane) {
    for (int c = 2 * lane; c < n; c += 128) { unsigned* q = (unsigned*)(hr + c0 + c); const unsigned u = *q; *q = pk2(bflo(u) * f, bfhi(u) * f); }
}
__device__ __forceinline__ void prep_token(bf16* hr, int t, const f32x2* T64, const f32x2* T32, int lane) {
    float sq = 0.f, skv = 0.f;
    { const unsigned long long u = *((const unsigned long long*)(hr + HC_CQ) + lane); const unsigned a = (unsigned)u, b = (unsigned)(u >> 32);
      sq = bflo(a) * bflo(a) + bfhi(a) * bfhi(a) + bflo(b) * bflo(b) + bfhi(b) * bfhi(b);
      const unsigned c = *((const unsigned*)(hr + HC_CKV) + lane); skv = bflo(c) * bflo(c) + bfhi(c) * bfhi(c); }
    const float rq = 1.0f / sqrtf(wave_sum(sq) * (1.f / 256.f) + RMS_EPS), rkv = 1.0f / sqrtf(wave_sum(skv) * (1.f / 128.f) + RMS_EPS);
    const f32x2* t64 = T64 + t * 32; const f32x2* t32 = T32 + t * 16;
    for (int e = lane; e < 256; e += 64) { bf16* q = hr + HC_QEFF + (e >> 6) * 96 + (e & 63); *q = (bf16)f2bf(bf2f(*q) * (rq * QSC_MLA)); }
    for (int hd = 0; hd < 4; ++hd) rope_inplace(hr, HC_QEFF + hd * 96 + 64, 1, 16, t32, rq * QSC_MLA, lane);
    scale_inplace(hr, HC_KVEFF, 512, rkv, lane);
    rope_inplace(hr, HC_KROPE, 1, 16, t32, 1.f, lane);
    rope_inplace(hr, HC_NSAQ, 4, 32, t64, QSC_64, lane);
    rope_inplace(hr, HC_KCMP, 1, 32, t64, 1.f, lane);
    rope_inplace(hr, HC_KSLC, 1, 32, t64, 1.f, lane);
    rope_inplace(hr, HC_KWIN, 1, 32, t64, 1.f, lane);
    rope_inplace(hr, HC_DSAQ, 4, 32, t64, QSC_64, lane);
    rope_inplace(hr, HC_DSAK, 1, 32, t64, 1.f, lane);
    rope_inplace(hr, HC_IDXQ, 8, 16, t32, 1.f, lane);
    rope_inplace(hr, HC_IDXK, 1, 16, t32, 1.f, lane);
    if (lane < 12) { bf16* q = hr + HC_GATE + lane; *q = (bf16)f2bf(1.0f / (1.0f + __expf(-bf2f(*q)))); }
    else if (lane < 20) { bf16* q = hr + HC_IDXW + (lane - 12); *q = (bf16)f2bf(bf2f(*q) * 0.0625f); }
    scale_inplace(hr, HC_SBQ, 256, 0.125f, lane);
}
struct PrepCls { int type; float f; int fi; };
__device__ __forceinline__ PrepCls prep_classify(int k, int L, float rqf, float rkv) {
    PrepCls c; c.type = 0; c.f = 1.f; c.fi = 0;
    const int d64 = (8 * L) & 63, d32 = (8 * L) & 31;
    const int r64 = (d64 & 31) | ((d64 >= 32) ? 256 : 0), r32v = (d32 & 15) | ((d32 >= 16) ? 256 : 0);
    if (k == 0) { if ((L >= 48 && L < 52) || (L >= 56 && L < 60)) { c.type = 3; c.fi = r32v; } else if (L >= 52 && L < 55) c.type = 4; }
    else if (k == 1) { if (L < 48) { const int d = (8 * L) % 96; c.f = rqf; if (d < 64) c.type = 1; else { c.type = 3; c.fi = ((d - 64) & 15) | ((d >= 80) ? 256 : 0); } } else { c.type = 1; c.f = rkv; } }
    else if (k == 2) { if (L < 48) { c.type = 1; c.f = rkv; } else { c.type = 2; c.f = QSC_64; c.fi = r64; } }
    else if (k == 3) { if (L < 16) { c.type = 2; c.f = QSC_64; c.fi = r64; } else if (((L >> 3) & 1) == 0) { c.type = 2; c.fi = r64; } }
    else if (k == 4) { if (L < 32) { c.type = 2; c.f = QSC_64; c.fi = r64; } else if (L < 40) { c.type = 2; c.fi = r64; } else if (L >= 48) { c.type = 3; c.fi = r32v; } }
    else { if (L < 16) { c.type = 3; c.fi = r32v; } }
    return c;
}
__device__ __forceinline__ void prep_load(const bf16* hr, u32x4 (&raw)[6], int lane) {
#pragma unroll
    for (int k = 0; k < 6; ++k) { const bool need = (prep_classify(k, lane, 1.f, 1.f).type != 0) || (k == 0 && lane < 48);
        raw[k] = need ? *((const u32x4*)(hr + 512 * k) + lane) : (u32x4){0u, 0u, 0u, 0u}; }
}
struct PrepTab { f32x4 c64[4], c32[4], c32b[4]; };
__device__ __forceinline__ void prep_tab_load(PrepTab& T, int t, const f32x2* T64, const f32x2* T32, int lane) {
    const int d64 = (8 * lane) & 63, d32 = (8 * lane) & 31, d1 = (8 * lane) % 96;
    const f32x4* p64 = (const f32x4*)(T64 + t * 32 + (d64 & 31)); const f32x4* p32 = (const f32x4*)(T32 + t * 16 + (d32 & 15)); const f32x4* p32b = (const f32x4*)(T32 + t * 16 + ((d1 >= 64) ? ((d1 - 64) & 15) : 0));
#pragma unroll
    for (int j = 0; j < 4; ++j) { T.c64[j] = p64[j]; T.c32[j] = p32[j]; T.c32b[j] = p32b[j]; }
}
__device__ __forceinline__ void prep_row(bf16* hr, u32x4 (&raw)[6], int t, const PrepTab& TB, int lane) {
    float ss = 0.f;
#pragma unroll
    for (int j = 0; j < 4; ++j) { const float a = bflo(raw[0][j]), b = bfhi(raw[0][j]); ss += a * a + b * b; }
    const float rq = 1.0f / sqrtf(wave_sum(lane < 32 ? ss : 0.f) * (1.f / 256.f) + RMS_EPS), rkv = 1.0f / sqrtf(wave_sum((lane >= 32 && lane < 48) ? ss : 0.f) * (1.f / 128.f) + RMS_EPS);
#pragma unroll
    for (int k = 0; k < 6; ++k) {
        const PrepCls c = prep_classify(k, lane, rq * QSC_MLA, rkv);
        const bool rope = (c.type == 2 || c.type == 3);
        f32x4 cs[4];
#pragma unroll
        for (int j = 0; j < 4; ++j) cs[j] = (k == 1) ? TB.c32b[j] : ((k == 2 || k == 3) ? TB.c64[j] : ((k == 4) ? ((c.type == 2) ? TB.c64[j] : TB.c32[j]) : TB.c32[j]));
        u32x4 p4, p2;
#pragma unroll
        for (int j = 0; j < 4; ++j) { p4[j] = (unsigned)sx_i<4>((int)raw[k][j]); p2[j] = (unsigned)sx_i<2>((int)raw[k][j]); }
        const u32x4 pr = (c.type == 2) ? p4 : p2;
        const bool second = (c.fi & 256) != 0;
        float o[8];
#pragma unroll
        for (int j = 0; j < 4; ++j) {
#pragma unroll
            for (int e = 0; e < 2; ++e) { const float z = e ? bfhi(raw[k][j]) : bflo(raw[k][j]), zp = e ? bfhi(pr[j]) : bflo(pr[j]);
                const float cc = cs[j][2 * e], sn = cs[j][2 * e + 1];
                float v = z * c.f;
                if (rope) v = (second ? (zp * sn + z * cc) : (z * cc - zp * sn)) * c.f;
                o[2 * j + e] = v; } }
        if (c.type == 4) {
#pragma unroll
            for (int e = 0; e < 8; ++e) { const float z = (e & 1) ? bfhi(raw[k][e >> 1]) : bflo(raw[k][e >> 1]); const int col = 8 * lane + e;
                o[e] = (col < HC_IDXW) ? 1.0f / (1.0f + __expf(-z)) : (col < HC_IDXW + 8 ? z * 0.0625f : z); } }
        if (c.type != 0) { u32x4 w; w.x = pk2(o[0], o[1]); w.y = pk2(o[2], o[3]); w.z = pk2(o[4], o[5]); w.w = pk2(o[6], o[7]); *((u32x4*)(hr + 512 * k) + lane) = w; }
    }
}
__device__ __forceinline__ void compress_item(PP p, int l, int item, LAS float* zs  , int lane) {
    const int kv = item / (BATCH * 128), rem = item % (BATCH * 128), b = rem / 128, n = rem % 128;
    if (n == 127) { ((bf16*)(p->ws + WS_KC))[((size_t)(kv * BATCH + b) * 128 + 127) * 64 + lane] = 0; return; }
    const bf16* hb = (const bf16*)(p->ws + WS_BIG) + (size_t)b * SEQ * NH + (kv ? HC_VCMP : HC_KCMP);
    const f32x2* T64 = (const f32x2*)(p->ws + WS_TAB);
    for (int i = 0; i < 32; ++i) { const int t = 16 * n + i; const bf16* zr = hb + (size_t)t * NH; float v;
        if (kv) v = bf2f(zr[lane]);
        else { const int fi = lane & 31; const f32x2 cs = T64[t * 32 + fi]; const float z1 = bf2f(zr[fi]), z2 = bf2f(zr[fi + 32]); v = (lane < 32) ? (z1 * cs.x - z2 * cs.y) : (z1 * cs.y + z2 * cs.x); }
        zs[i * 64 + lane] = v; }
    LDS_WAIT(); asm volatile("" ::: "memory");
    const float* w1 = p->in[kv ? I_WV1 : I_WK1] + (size_t)l * 2048 * 64; const float* w2 = p->in[kv ? I_WV2 : I_WK2] + (size_t)l * 64 * 64;
    float a = 0.f; for (int pp = 0; pp < 32; ++pp) a += ((const float*)(p->ws + WS_CBIAS))[((l * 2 + kv) * 32 + pp) * 64 + lane];
    for (int r = 0; r < 2048; r += 4) { const f32x4 z = *(const LAS f32x4*)(zs + r);
        a += z.x * w1[(r + 0) * 64 + lane]; a += z.y * w1[(r + 1) * 64 + lane]; a += z.z * w1[(r + 2) * 64 + lane]; a += z.w * w1[(r + 3) * 64 + lane]; }
    { const float u = 0.7978845608028654f * (a + 0.044715f * a * a * a); const float th = 1.0f - 2.0f / (__expf(2.0f * u) + 1.0f); a = 0.5f * a * (1.0f + th); }
    float o = 0.f;
    for (int j = 0; j < 64; ++j) o += __shfl(a, j) * w2[j * 64 + lane];
    bf16* kc = (bf16*)(p->ws + WS_KC) + ((size_t)(kv * BATCH + b) * 128 + n) * 64;
    kc[lane] = (bf16)f2bf(o);
    LDS_WAIT(); asm volatile("" ::: "memory");
}
template <int N> __device__ __forceinline__ float dot_row(const LAS float* q, const bf16* k) {
    float s = 0.f;
#pragma unroll 2
    for (int c = 0; c < N; c += 8) { const v4u kv = *(const v4u*)(k + c); const f32x4 q0 = *(const LAS f32x4*)(q + c), q1 = *(const LAS f32x4*)(q + c + 4);
        s += q0.x * bflo(kv.x) + q0.y * bfhi(kv.x) + q0.z * bflo(kv.y) + q0.w * bfhi(kv.y) + q1.x * bflo(kv.z) + q1.y * bfhi(kv.z) + q1.z * bflo(kv.w) + q1.w * bfhi(kv.w); }
    return s;
}
template <int DQ1, int DQ2, class Valid>
__device__ __forceinline__ float attn_naive(const LAS float* qs, const bf16* k1, const bf16* k2, const bf16* v, int ldk, int jlo, int jhi, const Valid& valid, int lane, float& l_out) {
    float m = -INFINITY, l = 0.f, o = 0.f;
    for (int j0 = jlo; j0 <= jhi; j0 += 64) {
        const int key = j0 + lane; const bool ok = valid(key);
        unsigned long long bal = __ballot(ok);
        if (bal == 0ull) continue;
        float s = -INFINITY;
        if (ok) { s = dot_row<DQ1>(qs, k1 + (size_t)key * ldk); if constexpr (DQ2 > 0) s += dot_row<DQ2>(qs + DQ1, k2 + (size_t)key * ldk); }
        const float mn = fmaxf(m, wave_max(s)), al = ex2(m - mn), pr = ok ? ex2(s - mn) : 0.f;
        l = l * al + wave_sum(pr); o *= al; m = mn;
        while (bal) { const int jj = __builtin_ctzll(bal); bal &= bal - 1ull; o += __shfl(pr, jj) * bf2f(v[(size_t)(j0 + jj) * ldk + lane]); }
    }
    l_out = l; return o;
}
__device__ __forceinline__ void put_y(bf16* ycat, float* sumsq, int token, int g, int hd, float val, int lane) {
    ycat[(size_t)token * DM + g * 256 + hd * 64 + lane] = (bf16)f2bf(val);
}
__device__ __forceinline__ unsigned dsa_select(const bf16* hb, const bf16* hr, int t, LAS float* ws_, unsigned* bm, int lane_in) {
    int lane = lane_in; OPAQUE_V(lane);
    LAS float* qi = ws_; LAS float* wq = ws_ + 256; LAS float* sc = ws_ + 1024;
    for (int c = lane; c < 256; c += 64) qi[c] = bf2f(hr[HC_IDXQ + c]);
    if (lane < 8) wq[lane] = bf2f(hr[HC_IDXW + lane]);
    LDS_WAIT(); asm volatile("" ::: "memory");
    const int nt = (t >> 6) + 1;
    for (int i = 0; i < nt; ++i) { const int key = 64 * i + lane; const bf16* kr = hb + (size_t)key * NH + HC_IDXK; float acc = 0.f;
#pragma unroll 1
        for (int hh = 0; hh < 8; ++hh) acc += wq[hh] * fmaxf(dot_row<32>(qi + hh * 32, kr), 0.f);
        sc[key] = (key <= t) ? acc : -3.0e38f; }
    LDS_WAIT(); asm volatile("" ::: "memory");
    float v[32];
#pragma unroll
    for (int i = 0; i < 32; ++i) v[i] = (i < nt) ? sc[i * 64 + lane] : -3.0e38f;
    float thr = -3.0e38f; bool tie = false; int need = 0;
    const bool all = (t < 256);
    if (!all) {
#define CNT_GE(x, c) do { c = 0; _Pragma("unroll") for (int i_ = 0; i_ < 32; ++i_) c += __builtin_popcountll(__ballot(v[i_] >= (x))); } while (0)
#define CNT_GT(x, c) do { c = 0; _Pragma("unroll") for (int i_ = 0; i_ < 32; ++i_) c += __builtin_popcountll(__ballot(v[i_] > (x))); } while (0)
        float mx = -3.0e38f, mn = 3.0e38f;
#pragma unroll
        for (int i = 0; i < 32; ++i) { mx = fmaxf(mx, v[i]); mn = fminf(mn, (v[i] > -1.0e38f) ? v[i] : 3.0e38f); }
        float hi = wave_max(mx), lo = wave_min(mn); int c;
        CNT_GE(hi, c);
        if (c >= 256) { thr = hi; tie = (c > 256); }
        else for (;;) { const float mid = 0.5f * (lo + hi);
            if (!(mid > lo && mid < hi)) { thr = lo; tie = true; break; }
            CNT_GE(mid, c);
            if (c == 256) { thr = mid; break; }
            if (c > 256) lo = mid; else hi = mid; }
        if (tie) { CNT_GT(thr, c); need = 256 - c; }
#undef CNT_GE
#undef CNT_GT
    }
    unsigned sel = 0u;
#pragma unroll
    for (int i = 0; i < 32; ++i) {
        unsigned long long mask;
        if (all) mask = __ballot(64 * i + lane <= t);
        else { const unsigned long long gt = __ballot(v[i] > thr), eq = __ballot(v[i] == thr); unsigned long long take = eq;
            if (tie) { const int ce = __builtin_popcountll(eq); if (ce <= need) need -= ce; else { unsigned long long mm = eq; take = 0ull; for (int q = 0; q < need; ++q) { const unsigned long long bb = mm & (~mm + 1ull); take |= bb; mm ^= bb; } need = 0; } }
            mask = gt | take; }
        if (lane < 2) bm[2 * i + lane] = (unsigned)(mask >> (32 * lane));
        sel |= (unsigned)((mask >> lane) & 1ull) << i;
    }
    return sel;
}
__device__ __forceinline__ unsigned nsa_cmp_select(const bf16* hr, const bf16* kcb, const bf16* vcb, int t, LAS float* scr, LAS float* oc, int lane) {
    LAS float* qs = scr; LAS float* ps = scr + 64;
    const int nvis = (t >= 31) ? (((t - 31) >> 4) + 1) : 0;
    float ps0 = 0.f, ps1 = 0.f;
    for (int hd = 0; hd < 4; ++hd) {
        qs[lane] = bf2f(hr[HC_NSAQ + 64 * hd + lane]);
        LDS_WAIT(); asm volatile("" ::: "memory");
        float p0 = 0.f, p1 = 0.f, o = 0.f;
        if (nvis > 0) {
            const float s0 = (lane < nvis) ? dot_row<64>(qs, kcb + lane * 64) : -INFINITY, s1 = (64 + lane < nvis) ? dot_row<64>(qs, kcb + (64 + lane) * 64) : -INFINITY;
            const float mx = wave_max(fmaxf(s0, s1));
            p0 = (lane < nvis) ? ex2(s0 - mx) : 0.f; p1 = (64 + lane < nvis) ? ex2(s1 - mx) : 0.f;
            const float inv = 1.0f / fmaxf(wave_sum(p0 + p1), 1e-30f); p0 *= inv; p1 *= inv;
            for (int n = 0; n < nvis; ++n) { const float pn = (n < 64) ? __shfl(p0, n) : __shfl(p1, n - 64); o += pn * bf2f(vcb[n * 64 + lane]); }
        }
        ps0 += p0; ps1 += p1; oc[hd * 64 + lane] = o;
        LDS_WAIT(); asm volatile("" ::: "memory");
    }
    ps[lane] = ps0; ps[64 + lane] = ps1;
    LDS_WAIT(); asm volatile("" ::: "memory");
    const int cur = t >> 6;
    float val = -3.4e38f;
    if (lane < 32) { float imp = 0.f;
        for (int n = 4 * lane - 1; n <= 4 * lane + 3; ++n) if (n >= 0 && n <= 126) imp += ps[n];
        val = (lane == 0 || lane == cur || lane == cur - 1) ? 1.0e4f : ((lane <= cur) ? imp : -1.0e30f); }
    unsigned selmask = 0u;
    for (int r = 0; r < 8; ++r) { const float mx = wave_max(val); const unsigned long long bal = __ballot(val == mx); const int first = __builtin_ctzll(bal);
        selmask |= 1u << first; if (lane == first) val = -3.4e38f; }
    return selmask;
}
template <int GROUPS  >
__device__ __forceinline__ void attn_token_naive(PP p, int token, LAS float* ws_, int lane_in) {
    int lane = lane_in; OPAQUE_V(lane);
    const int b = token / SEQ, t = token % SEQ;
    const bf16* hb = (const bf16*)(p->ws + WS_BIG) + (size_t)b * SEQ * NH; const bf16* hr = hb + (size_t)t * NH;
    bf16* ycat = (bf16*)(p->ws + WS_YCAT); float* sumsq = (float*)(p->ws + WS_SUMSQ);
    LAS float* qs = ws_;
    if constexpr (GROUPS & 1) for (int hd = 0; hd < 4; ++hd) {
        for (int c = lane; c < 96; c += 64) qs[c] = bf2f(hr[HC_QEFF + 96 * hd + c]);
        LDS_WAIT(); asm volatile("" ::: "memory");
        float l; const float o = attn_naive<64, 32>(qs, hb + HC_KVEFF + 128 * hd, hb + HC_KROPE, hb + HC_KVEFF + 128 * hd + 64, NH, 0, t & ~63, [t](int key) { return key <= t; }, lane, l);
        put_y(ycat, sumsq, token, 0, hd, o / fmaxf(l, 1e-30f), lane);
        LDS_WAIT(); asm volatile("" ::: "memory");
    }
    if constexpr (GROUPS & 2) for (int hd = 0; hd < 4; ++hd) {
        qs[lane] = bf2f(hr[HC_SBQ + 64 * hd + lane]);
        LDS_WAIT(); asm volatile("" ::: "memory");
        float o = 0.f, carry = 0.f;
        if (t > 0) for (int j0 = (t - 1) & ~63; j0 >= 0; j0 -= 64) {
            const int key = j0 + lane; const bool ok = key < t;
            const float z = ok ? dot_row<64>(qs, hb + (size_t)key * NH + HC_SBK + 64 * hd) : 0.f;
            const float lm = ok ? -(fmaxf(z, 0.f) + __logf(1.0f + __expf(-fabsf(z)))) : 0.f;
            float incl = lm;
#pragma unroll
            for (int off = 1; off < 64; off <<= 1) { const float u = __shfl_down(incl, off); if (lane + off < 64) incl += u; }
            const float a = ok ? __expf(z + incl + carry) : 0.f;
            carry += __shfl(incl, 0);
            unsigned long long bal = __ballot(ok);
            while (bal) { const int jj = __builtin_ctzll(bal); bal &= bal - 1ull; o += __shfl(a, jj) * bf2f(hb[(size_t)(j0 + jj) * NH + HC_SBV + 64 * hd + lane]); }
            if (carry < -104.f) break;
        }
        put_y(ycat, sumsq, token, 3, hd, o, lane);
        LDS_WAIT(); asm volatile("" ::: "memory");
    }
    if constexpr (GROUPS & 4) {
        const bf16* kcb = (const bf16*)(p->ws + WS_KC) + (size_t)b * 128 * 64; const bf16* vcb = kcb + (size_t)BATCH * 128 * 64;
        const unsigned selmask = nsa_cmp_select(hr, kcb, vcb, t, ws_, ws_ + 512, lane);
        LAS float* oc = ws_ + 512;
        for (int hd = 0; hd < 4; ++hd) {
            qs[lane] = bf2f(hr[HC_NSAQ + 64 * hd + lane]);
            LDS_WAIT(); asm volatile("" ::: "memory");
            float ls, lw;
            const float os = attn_naive<64, 0>(qs, hb + HC_KSLC, nullptr, hb + HC_VSLC, NH, 0, t & ~63, [t, selmask](int key) { return key <= t && ((selmask >> (key >> 6)) & 1u); }, lane, ls);
            const int klo = t - 511;
            const float ow = attn_naive<64, 0>(qs, hb + HC_KWIN, nullptr, hb + HC_VWIN, NH, (klo > 0 ? klo : 0) & ~63, t & ~63, [t, klo](int key) { return key <= t && key >= klo; }, lane, lw);
            const float g0 = bf2f(hr[HC_GATE + hd]), g1 = bf2f(hr[HC_GATE + 4 + hd]), g2 = bf2f(hr[HC_GATE + 8 + hd]);
            put_y(ycat, sumsq, token, 1, hd, g0 * oc[hd * 64 + lane] + g1 * os / fmaxf(ls, 1e-30f) + g2 * ow / fmaxf(lw, 1e-30f), lane);
            LDS_WAIT(); asm volatile("" ::: "memory");
        }
    }
    if constexpr (GROUPS & 8) {
        const unsigned sel = dsa_select(hb, hr, t, ws_, (unsigned*)(p->ws + WS_BITM) + (size_t)token * 64, lane);
        for (int hd = 0; hd < 4; ++hd) {
            qs[lane] = bf2f(hr[HC_DSAQ + 64 * hd + lane]);
            LDS_WAIT(); asm volatile("" ::: "memory");
            float l; const float o = attn_naive<64, 0>(qs, hb + HC_DSAK, nullptr, hb + HC_DSAV, NH, 0, t & ~63, [sel](int key) { return ((sel >> (key >> 6)) & 1u) != 0u; }, lane, l);
            put_y(ycat, sumsq, token, 2, hd, o / fmaxf(l, 1e-30f), lane);
            LDS_WAIT(); asm volatile("" ::: "memory");
        }
    }
}
__device__ __forceinline__ void gnorm_phase(const bf16* yc, unsigned char* yq8, int gw, int NGW, int lane) {
    constexpr int U = 4;
    for (int m0 = gw; m0 < M; m0 += U * NGW) {
        u32x4 raw[U][2];
#pragma unroll
        for (int u = 0; u < U; ++u) { const int m = (m0 + u * NGW < M) ? m0 + u * NGW : m0; const u32x4* xr = (const u32x4*)(yc + (size_t)m * DM) + lane; raw[u][0] = xr[0]; raw[u][1] = xr[64]; }
#pragma unroll
        for (int u = 0; u < U; ++u) { const int m = m0 + u * NGW; if (m >= M) break;
            unsigned long long* qw = (unsigned long long*)(yq8 + (size_t)m * DM) + lane;
#pragma unroll
            for (int h = 0; h < 2; ++h) { float v[8], ss = 0.f;
#pragma unroll
                for (int k = 0; k < 4; ++k) { v[2 * k] = bflo(raw[u][h][k]); v[2 * k + 1] = bfhi(raw[u][h][k]); }
#pragma unroll
                for (int k = 0; k < 8; ++k) ss += v[k] * v[k];
                ss = half_sum(ss, lane >> 5);
                const float rs = 1.0f / sqrtf(ss * (1.f / 256.f) + RMS_EPS);
                int lo = __builtin_amdgcn_cvt_pk_fp8_f32(v[0] * rs, v[1] * rs, 0, false); lo = __builtin_amdgcn_cvt_pk_fp8_f32(v[2] * rs, v[3] * rs, lo, true);
                int hi = __builtin_amdgcn_cvt_pk_fp8_f32(v[4] * rs, v[5] * rs, 0, false); hi = __builtin_amdgcn_cvt_pk_fp8_f32(v[6] * rs, v[7] * rs, hi, true);
                qw[64 * h] = (unsigned long long)(unsigned)lo | ((unsigned long long)(unsigned)hi << 32); }
        }
    }
}
namespace fa {
typedef short s16x4 __attribute__((ext_vector_type(4)));
typedef short v4i16_t __attribute__((ext_vector_type(4)));
__device__ __forceinline__ int crow(int r, int hi) { return (r & 3) + 8 * (r >> 2) + 4 * hi; }
__device__ __forceinline__ unsigned cvtpk(float lo, float hi) { unsigned r; asm("v_cvt_pk_bf16_f32 %0, %1, %2" : "=v"(r) : "v"(lo), "v"(hi)); return r; }
template <int DQK> struct Stage { static constexpr int KB = DQK * 128, VB = 8192, BYTES = KB + VB; };
template <int DQK> struct Loader {
    v4u k0, k1, v;
    __device__ __forceinline__ void issue(const bf16* k1b, const bf16* k2b, const bf16* vb, int ld, int key0, int tid) {
        const int row = tid & 63, ch = tid >> 6;
        { const int kr = 8 * ch + (row >> 3), sl = row & 7; k0 = *(const v4u*)(k1b + (size_t)(key0 + kr) * ld + ((sl ^ ((kr >> 1) & 7)) << 3)); }
        if constexpr (DQK == 96) { if (tid < 256) { const int kr = 16 * ch + (row >> 2), sl = row & 3; k1 = *(const v4u*)(k2b + (size_t)(key0 + kr) * ld + ((sl ^ ((kr >> 2) & 3)) << 3)); } }
        v = *(const v4u*)(vb + (size_t)(key0 + 16 * (ch & 3) + (row >> 2)) * ld + (ch >> 2) * 32 + (row & 3) * 8);
    }
    __device__ __forceinline__ void commit(LAS unsigned char* st, int tid) {
        *(LAS v4u*)(st + tid * 16) = k0;
        if constexpr (DQK == 96) { if (tid < 256) *(LAS v4u*)(st + 8192 + tid * 16) = k1; }
        *(LAS v4u*)(st + Stage<DQK>::KB + tid * 16) = v;
    }
};
template <int DQK> __device__ __forceinline__ void qk_tile(f32x16& p0, f32x16& p1, const LAS unsigned char* kst, const bf16x8 (&qr)[DQK / 16], int r32, int hi, const f32x16& cinit) {
    const LAS unsigned char* kb = kst + r32 * 128; const int x7 = hi ^ ((r32 >> 1) & 7);
#pragma unroll
    for (int d0 = 0; d0 < 4; ++d0) { const LAS unsigned char* q = kb + (((2 * d0) ^ x7) << 4); const bf16x8 b0 = *(const LAS bf16x8*)q, b1 = *(const LAS bf16x8*)(q + 4096);
        if (d0 == 0) { p0 = __builtin_amdgcn_mfma_f32_32x32x16_bf16(b0, qr[0], cinit, 0, 0, 0); p1 = __builtin_amdgcn_mfma_f32_32x32x16_bf16(b1, qr[0], cinit, 0, 0, 0); }
        else { p0 = __builtin_amdgcn_mfma_f32_32x32x16_bf16(b0, qr[d0], p0, 0, 0, 0); p1 = __builtin_amdgcn_mfma_f32_32x32x16_bf16(b1, qr[d0], p1, 0, 0, 0); } }
    if constexpr (DQK == 96) { const LAS unsigned char* kp = kst + 8192 + r32 * 64; const int x3 = hi ^ ((r32 >> 2) & 3);
#pragma unroll
        for (int d0 = 0; d0 < 2; ++d0) { const LAS unsigned char* q = kp + (((2 * d0) ^ x3) << 4); const bf16x8 b0 = *(const LAS bf16x8*)q, b1 = *(const LAS bf16x8*)(q + 2048);
            p0 = __builtin_amdgcn_mfma_f32_32x32x16_bf16(b0, qr[4 + d0], p0, 0, 0, 0); p1 = __builtin_amdgcn_mfma_f32_32x32x16_bf16(b1, qr[4 + d0], p1, 0, 0, 0); } }
}
template <int DQK> __device__ __forceinline__ void qk_tile(f32x16& p0, f32x16& p1, const LAS unsigned char* kst, const bf16x8 (&qr)[DQK / 16], int r32, int hi) {
    f32x16 z = (f32x16){}; qk_tile<DQK>(p0, p1, kst, qr, r32, hi, z);
}
template <int DQK> __device__ __forceinline__ void qk_tile_pf(f32x16& p0, f32x16& p1, const LAS unsigned char* kst, const bf16x8 (&qr)[DQK / 16], int r32, int hi, const f32x16& cinit) {
    const LAS unsigned char* kb = kst + r32 * 128; const int x7 = hi ^ ((r32 >> 1) & 7);
    bf16x8 kf0[DQK / 16], kf1[DQK / 16];
#pragma unroll
    for (int d0 = 0; d0 < 4; ++d0) { const LAS unsigned char* q = kb + (((2 * d0) ^ x7) << 4); kf0[d0] = *(const LAS bf16x8*)q; kf1[d0] = *(const LAS bf16x8*)(q + 4096); }
    if constexpr (DQK == 96) { const LAS unsigned char* kp = kst + 8192 + r32 * 64; const int x3 = hi ^ ((r32 >> 2) & 3);
#pragma unroll
        for (int d0 = 0; d0 < 2; ++d0) { const LAS unsigned char* q = kp + (((2 * d0) ^ x3) << 4); kf0[4 + d0] = *(const LAS bf16x8*)q; kf1[4 + d0] = *(const LAS bf16x8*)(q + 2048); } }
    __builtin_amdgcn_sched_barrier(0);
    p0 = __builtin_amdgcn_mfma_f32_32x32x16_bf16(kf0[0], qr[0], cinit, 0, 0, 0); p1 = __builtin_amdgcn_mfma_f32_32x32x16_bf16(kf1[0], qr[0], cinit, 0, 0, 0);
#pragma unroll
    for (int d0 = 1; d0 < DQK / 16; ++d0) { p0 = __builtin_amdgcn_mfma_f32_32x32x16_bf16(kf0[d0], qr[d0], p0, 0, 0, 0); p1 = __builtin_amdgcn_mfma_f32_32x32x16_bf16(kf1[d0], qr[d0], p1, 0, 0, 0); }
}
template <int DQK> __device__ __forceinline__ void qk_tile_pf(f32x16& p0, f32x16& p1, const LAS unsigned char* kst, const bf16x8 (&qr)[DQK / 16], int r32, int hi) {
    f32x16 z = (f32x16){}; qk_tile_pf<DQK>(p0, p1, kst, qr, r32, hi, z);
}
__device__ __forceinline__ void pv_tile(f32x16 (&o)[2], const LAS unsigned char* vst, const f32x16& p0, const f32x16& p1, int lane) {
    const int hi = lane >> 5;
    u32x4 pw[4];
#pragma unroll
    for (int j = 0; j < 4; ++j) { pw[0][j] = cvtpk(p0[2 * j], p0[2 * j + 1]); pw[1][j] = cvtpk(p0[8 + 2 * j], p0[9 + 2 * j]); pw[2][j] = cvtpk(p1[2 * j], p1[2 * j + 1]); pw[3][j] = cvtpk(p1[8 + 2 * j], p1[9 + 2 * j]); }
    const LAS unsigned char* vp = vst + ((lane >> 4) & 1) * 32 + (lane & 3) * 8 + (4 * hi + ((lane & 15) >> 2)) * 64;
#pragma unroll
    for (int d0 = 0; d0 < 2; ++d0)
#pragma unroll
        for (int ks = 0; ks < 4; ++ks) {
            const s16x4 lo = __builtin_bit_cast(s16x4, __builtin_amdgcn_ds_read_tr16_b64_v4i16((LAS v4i16_t*)(vp + d0 * 4096 + ks * 1024)));
            const s16x4 hh = __builtin_bit_cast(s16x4, __builtin_amdgcn_ds_read_tr16_b64_v4i16((LAS v4i16_t*)(vp + d0 * 4096 + ks * 1024 + 512)));
            const bf16x8 vf = (bf16x8){lo[0], lo[1], lo[2], lo[3], hh[0], hh[1], hh[2], hh[3]};
            o[d0] = __builtin_amdgcn_mfma_f32_32x32x16_bf16(__builtin_bit_cast(bf16x8, pw[ks]), vf, o[d0], 0, 0, 0); }
}
__device__ __forceinline__ void pv_tile_pf(f32x16 (&o)[2], const LAS unsigned char* vst, const f32x16& p0, const f32x16& p1, int lane) {
    const int hi = lane >> 5;
    const LAS unsigned char* vp = vst + ((lane >> 4) & 1) * 32 + (lane & 3) * 8 + (4 * hi + ((lane & 15) >> 2)) * 64;
    bf16x8 vf[2][4];
#pragma unroll
    for (int ks = 0; ks < 4; ++ks)
#pragma unroll
        for (int d0 = 0; d0 < 2; ++d0) {
            const s16x4 lo = __builtin_bit_cast(s16x4, __builtin_amdgcn_ds_read_tr16_b64_v4i16((LAS v4i16_t*)(vp + d0 * 4096 + ks * 1024)));
            const s16x4 hh = __builtin_bit_cast(s16x4, __builtin_amdgcn_ds_read_tr16_b64_v4i16((LAS v4i16_t*)(vp + d0 * 4096 + ks * 1024 + 512)));
            vf[d0][ks] = (bf16x8){lo[0], lo[1], lo[2], lo[3], hh[0], hh[1], hh[2], hh[3]}; }
    u32x4 pw[4];
#pragma unroll
    for (int j = 0; j < 4; ++j) { pw[0][j] = cvtpk(p0[2 * j], p0[2 * j + 1]); pw[1][j] = cvtpk(p0[8 + 2 * j], p0[9 + 2 * j]); pw[2][j] = cvtpk(p1[2 * j], p1[2 * j + 1]); pw[3][j] = cvtpk(p1[8 + 2 * j], p1[9 + 2 * j]); }
    __builtin_amdgcn_sched_barrier(0);
#pragma unroll
    for (int ks = 0; ks < 4; ++ks)
#pragma unroll
        for (int d0 = 0; d0 < 2; ++d0) o[d0] = __builtin_amdgcn_mfma_f32_32x32x16_bf16(__builtin_bit_cast(bf16x8, pw[ks]), vf[d0][ks], o[d0], 0, 0, 0);
}
__device__ __forceinline__ void softmax_tile(f32x16& p0, f32x16& p1, f32x16 (&o)[2], float& m, float& l, LAS float* wsf, int r32, int hi) {
    float mx = fmaxf(p0[0], p1[0]);
#pragma unroll
    for (int r = 1; r < 16; ++r) mx = fmaxf(mx, fmaxf(p0[r], p1[r]));
    mx = x32_max(mx);
    const float mn = (mx > m + 8.0f) ? mx : m, ms = (mn == -INFINITY) ? 0.f : mn, f = ex2(m - ms);
    float s = 0.f;
#pragma unroll
    for (int r = 0; r < 16; ++r) { p0[r] = ex2(p0[r] - ms); p1[r] = ex2(p1[r] - ms); s += p0[r] + p1[r]; }
    l = l * f + s; m = mn;
    if (__any(f != 1.0f)) {
        if (hi == 0) wsf[r32] = f;
        asm volatile("s_waitcnt lgkmcnt(0)" ::: "memory");
#pragma unroll
        for (int r = 0; r < 16; ++r) { const float fr = wsf[crow(r, hi)]; o[0][r] *= fr; o[1][r] *= fr; }
        asm volatile("s_waitcnt lgkmcnt(0)" ::: "memory");
    }
}
__device__ __forceinline__ float max3f(float a, float b, float c) { float r; asm("v_max3_f32 %0, %1, %2, %3" : "=v"(r) : "v"(a), "v"(b), "v"(c)); return r; }
__device__ __forceinline__ float max2f(float a, float b) { float r; asm("v_max_f32_e32 %0, %1, %2" : "=v"(r) : "v"(a), "v"(b)); return r; }
#define FA_MX3(a, b, c) __builtin_fmaxf(__builtin_fmaxf((a), (b)), (c))
__device__ __forceinline__ void softmax_tile2(f32x16& p0, f32x16& p1, f32x16 (&o)[2], float& mref, float& l, f32x16& negm, LAS float* wsf, int r32, int hi) {
    float a = FA_MX3(p0[0], p0[1], p1[0]), b = FA_MX3(p0[2], p0[3], p1[1]); a = FA_MX3(a, p1[2], p1[3]);
#pragma unroll
    for (int r = 4; r < 16; r += 4) { a = FA_MX3(a, p0[r], p0[r + 1]); b = FA_MX3(b, p0[r + 2], p0[r + 3]); a = FA_MX3(a, p1[r], p1[r + 1]); b = FA_MX3(b, p1[r + 2], p1[r + 3]); }
    const float mx = x32_max(__builtin_fmaxf(a, b));
    const bool unset = (mref == -INFINITY), shift = (mx > 8.0f) || (unset && mx > -INFINITY);
    if (__any(shift)) {
        const float dl = shift ? mx : 0.f, f = unset ? 1.0f : ex2(-dl);
#pragma unroll
        for (int r = 0; r < 16; ++r) { p0[r] -= dl; p1[r] -= dl; }
        mref = (unset ? 0.f : mref) + dl; if (!shift && unset) mref = -INFINITY;
        const float nm = (mref == -INFINITY) ? 0.f : -mref;
#pragma unroll
        for (int r = 0; r < 16; ++r) negm[r] = nm;
        l *= f;
        if (hi == 0) wsf[r32] = f;
        asm volatile("s_waitcnt lgkmcnt(0)" ::: "memory");
#pragma unroll
        for (int r = 0; r < 16; ++r) { const float fr = wsf[crow(r, hi)]; o[0][r] *= fr; o[1][r] *= fr; }
        asm volatile("s_waitcnt lgkmcnt(0)" ::: "memory");
    }
    f32x2 s2 = (f32x2){0.f, 0.f};
#pragma unroll
    for (int r = 0; r < 16; r += 2) { p0[r] = ex2(p0[r]); p0[r + 1] = ex2(p0[r + 1]); p1[r] = ex2(p1[r]); p1[r + 1] = ex2(p1[r + 1]); s2 += (f32x2){p0[r], p0[r + 1]}; s2 += (f32x2){p1[r], p1[r + 1]}; }
    l += s2[0] + s2[1];
}
__device__ __forceinline__ void softmax_tile3(f32x16& p0, f32x16& p1, f32x16 (&o)[2], float& mref, float& l, f32x16& negm, bool& shifted, LAS float* wsf, int r32, int hi) {
    float a = FA_MX3(p0[0], p0[1], p1[0]), b = FA_MX3(p0[2], p0[3], p1[1]); a = FA_MX3(a, p1[2], p1[3]);
#pragma unroll
    for (int r = 4; r < 16; r += 4) { a = FA_MX3(a, p0[r], p0[r + 1]); b = FA_MX3(b, p0[r + 2], p0[r + 3]); a = FA_MX3(a, p1[r], p1[r + 1]); b = FA_MX3(b, p1[r + 2], p1[r + 3]); }
    const float mx = x32_max(__builtin_fmaxf(a, b));
    const bool need = (mx > 8.0f) || (l == 0.f && mx < -40.0f && mx > -INFINITY);
    if (__any(need)) {
        const float dl = need ? mx : 0.f, f = ex2(-dl);
#pragma unroll
        for (int r = 0; r < 16; ++r) { p0[r] -= dl; p1[r] -= dl; }
        mref += dl;
#pragma unroll
        for (int r = 0; r < 16; ++r) negm[r] = -mref;
        l *= f;
        if (hi == 0) wsf[r32] = f;
        asm volatile("s_waitcnt lgkmcnt(0)" ::: "memory");
#pragma unroll
        for (int r = 0; r < 16; ++r) { const float fr = wsf[crow(r, hi)]; o[0][r] *= fr; o[1][r] *= fr; }
        asm volatile("s_waitcnt lgkmcnt(0)" ::: "memory");
        shifted = true;
    }
    f32x2 s2 = (f32x2){0.f, 0.f};
#pragma unroll
    for (int r = 0; r < 16; r += 2) { p0[r] = ex2(p0[r]); p0[r + 1] = ex2(p0[r + 1]); p1[r] = ex2(p1[r]); p1[r + 1] = ex2(p1[r + 1]); s2 += (f32x2){p0[r], p0[r + 1]}; s2 += (f32x2){p1[r], p1[r + 1]}; }
    l += s2[0] + s2[1];
}
__device__ __forceinline__ void normalize_o(f32x16 (&o)[2], float l, LAS float* wsf, int r32, int hi) {
    const float lt = x32_sum(l);
    if (hi == 0) wsf[r32] = 1.0f / fmaxf(lt, 1e-30f);
    asm volatile("s_waitcnt lgkmcnt(0)" ::: "memory");
#pragma unroll
    for (int r = 0; r < 16; ++r) { const float fr = wsf[crow(r, hi)]; o[0][r] *= fr; o[1][r] *= fr; }
    asm volatile("s_waitcnt lgkmcnt(0)" ::: "memory");
}
__device__ __forceinline__ void store_o(const f32x16 (&o)[2], bf16* y, size_t row0, int ld, int col0, int r32, int hi) {
#pragma unroll
    for (int r = 0; r < 16; ++r) { bf16* yr = y + (row0 + crow(r, hi)) * ld + col0 + r32; yr[0] = (bf16)f2bf(o[0][r]); yr[32] = (bf16)f2bf(o[1][r]); }
}
template <int DQK> __device__ __forceinline__ void load_q(bf16x8 (&qr)[DQK / 16], const bf16* qrow  , int hi) {
#pragma unroll
    for (int d0 = 0; d0 < DQK / 16; ++d0) qr[d0] = *(const bf16x8*)(qrow + d0 * 16 + hi * 8);
}
}

__device__ __forceinline__ void mla_unit(const bf16* H, bf16* ycat, int b, int hd, int qb, LAS unsigned char* ldsL, int tid_in) {
    int tid = tid_in; OPAQUE_V(tid);
    const int lane = tid & 63, wave = __builtin_amdgcn_readfirstlane(tid >> 6), r32 = lane & 31, hi = lane >> 5;
    const bf16* hb = H + (size_t)b * SEQ * NH;
    const int q0w = qb * 256 + wave * 32;
    bf16x8 qr[6]; fa::load_q<96>(qr, hb + (size_t)(q0w + r32) * NH + HC_QEFF + 96 * hd, hi);
    const bf16* k1b = hb + HC_KVEFF + 128 * hd; const bf16* k2b = hb + HC_KROPE;
    const bf16* vb = k1b + 64;
    LAS float* wsf = (LAS float*)(ldsL + 2 * fa::Stage<96>::BYTES) + wave * 64;
    f32x16 o[2]; o[0] = (f32x16){}; o[1] = (f32x16){}; float m = 0.f, l = 0.f; f32x16 negm = (f32x16){}; bool shifted = false;
    const int ntiles = 4 * (qb + 1);
    fa::Loader<96> ld;
    __syncthreads();
    ld.issue(k1b, k2b, vb, NH, 0, tid); ld.commit(ldsL, tid);
    __syncthreads();
    for (int it = 0; it < ntiles; ++it) {
        const int key0 = it * 64; LAS unsigned char* st = ldsL + (it & 1) * fa::Stage<96>::BYTES;
        if (it + 1 < ntiles) ld.issue(k1b, k2b, vb, NH, key0 + 64, tid);
        if (key0 <= q0w + 31) {
            f32x16 p0, p1; if (shifted) fa::qk_tile_pf<96>(p0, p1, st, qr, r32, hi, negm); else fa::qk_tile_pf<96>(p0, p1, st, qr, r32, hi);
            if (key0 + 63 > q0w) { const int rel = q0w + r32 - key0 - 4 * hi;
#pragma unroll
                for (int r = 0; r < 16; ++r) { const int c = (r & 3) + 8 * (r >> 2); if (c > rel) p0[r] = -INFINITY; if (c + 32 > rel) p1[r] = -INFINITY; } }
            fa::softmax_tile3(p0, p1, o, m, l, negm, shifted, wsf, r32, hi);
            fa::pv_tile_pf(o, st + fa::Stage<96>::KB, p0, p1, lane);
        }
        if (it + 1 < ntiles) ld.commit(ldsL + ((it + 1) & 1) * fa::Stage<96>::BYTES, tid);
        __syncthreads();
    }
    fa::normalize_o(o, l, wsf, r32, hi);
    fa::store_o(o, ycat, (size_t)b * SEQ + q0w, DM, 0 * 256 + hd * 64, r32, hi);
}
__device__ __forceinline__ void sb_unit(const bf16* H, bf16* ycat, int b, int hd, int qb, LAS unsigned char* ldsL, int tid_in) {
    int tid = tid_in; OPAQUE_V(tid);
    const int lane = tid & 63, wave = __builtin_amdgcn_readfirstlane(tid >> 6), r32 = lane & 31, hi = lane >> 5;
    const bf16* hb = H + (size_t)b * SEQ * NH;
    const int q0w = qb * 256 + wave * 32, tq = q0w + r32;
    bf16x8 qr[4]; fa::load_q<64>(qr, hb + (size_t)tq * NH + HC_SBQ + 64 * hd, hi);
    const bf16* k1b = hb + HC_SBK + 64 * hd; const bf16* vb = hb + HC_SBV + 64 * hd;
    constexpr int SB_ = fa::Stage<64>::BYTES;
    volatile LAS int* flg = (volatile LAS int*)(ldsL + 2 * SB_ + 4096);
    f32x16 o[2]; o[0] = (f32x16){}; o[1] = (f32x16){}; float carry = 1.0f; bool done = false;
    const int tmax = 4 * qb + 3;
    fa::Loader<64> ld;
    __syncthreads();
    ld.issue(k1b, nullptr, vb, NH, tmax * 64, tid); ld.commit(ldsL, tid);
    __syncthreads();
    for (int it = 0;; ++it) {
        const int key0 = (tmax - it) * 64; const bool more = key0 > 0; LAS unsigned char* st = ldsL + (it & 1) * SB_;
        if (more) ld.issue(k1b, nullptr, vb, NH, key0 - 64, tid);
        if (!done && key0 <= q0w + 30) {
            f32x16 z0, z1; fa::qk_tile<64>(z0, z1, st, qr, r32, hi);
            f32x16 M0, M1;
            const int rel = tq - key0 - 4 * hi;
            constexpr float ECLAMP = (-80.f) * (-LOG2E);
            if (key0 + 63 < q0w) {
#pragma unroll
                for (int r = 0; r < 16; ++r) {
                    { const float e = ex2(fminf(z0[r] * (-LOG2E), ECLAMP)), bt = __builtin_amdgcn_rcpf(1.0f + e); z0[r] = bt; M0[r] = e * bt; }
                    { const float e = ex2(fminf(z1[r] * (-LOG2E), ECLAMP)), bt = __builtin_amdgcn_rcpf(1.0f + e); z1[r] = bt; M1[r] = e * bt; } }
            } else {
#pragma unroll
                for (int r = 0; r < 16; ++r) { const int c = (r & 3) + 8 * (r >> 2);
                    { const float e = ex2(fminf(z0[r] * (-LOG2E), ECLAMP)), bt = __builtin_amdgcn_rcpf(1.0f + e); const bool ok = c < rel; z0[r] = ok ? bt : 0.f; M0[r] = ok ? e * bt : 1.0f; }
                    { const float e = ex2(fminf(z1[r] * (-LOG2E), ECLAMP)), bt = __builtin_amdgcn_rcpf(1.0f + e); const bool ok = c + 32 < rel; z1[r] = ok ? bt : 0.f; M1[r] = ok ? e * bt : 1.0f; } }
            }
            float Gs[8], Go[8], SP[8];
#pragma unroll
            for (int g = 0; g < 4; ++g) { Gs[g] = (M0[4 * g] * M0[4 * g + 1]) * (M0[4 * g + 2] * M0[4 * g + 3]); Gs[4 + g] = (M1[4 * g] * M1[4 * g + 1]) * (M1[4 * g + 2] * M1[4 * g + 3]); }
#pragma unroll
            for (int j = 0; j < 8; ++j) Go[j] = x32_other(Gs[j], hi);
            SP[7] = 1.0f;
#pragma unroll
            for (int j = 6; j >= 0; --j) SP[j] = SP[j + 1] * (Gs[j + 1] * Go[j + 1]);
            const float total = SP[0] * (Gs[0] * Go[0]);
#pragma unroll
            for (int g = 0; g < 4; ++g) {
                float run0 = SP[g] * (hi == 0 ? Go[g] : 1.0f) * carry, run1 = SP[4 + g] * (hi == 0 ? Go[4 + g] : 1.0f) * carry;
#pragma unroll
                for (int i = 3; i >= 0; --i) { const int r = 4 * g + i;
                    z0[r] *= run0; run0 *= M0[r]; z1[r] *= run1; run1 *= M1[r]; }
            }
            fa::pv_tile(o, st + fa::Stage<64>::KB, z0, z1, lane);
            carry *= total;
            done = __all(carry == 0.f);
        }
        if (lane == 0) flg[(it & 1) * 8 + wave] = done ? 1 : 0;
        if (more) ld.commit(ldsL + ((it + 1) & 1) * SB_, tid);
        __syncthreads();
        int alld = 1;
#pragma unroll
        for (int w = 0; w < 8; ++w) alld &= flg[(it & 1) * 8 + w];
        if (alld || !more) break;
    }
    fa::store_o(o, ycat, (size_t)b * SEQ + q0w, DM, 3 * 256 + hd * 64, r32, hi);
}
__device__ __forceinline__ void dsa_unit(const bf16* H, const unsigned* BM, bf16* ycat, int b, int j, LAS unsigned char* ldsL, int tid_in) {
    int tid = tid_in; OPAQUE_V(tid);
    const int lane = tid & 63, wave = __builtin_amdgcn_readfirstlane(tid >> 6), r32 = lane & 31, hi = lane >> 5, qh = wave >> 2, hd = wave & 3;
    const bf16* hb = H + (size_t)b * SEQ * NH;
    const int q0w = j * 64 + qh * 32, tq = q0w + r32;
    bf16x8 qr[4]; fa::load_q<64>(qr, hb + (size_t)tq * NH + HC_DSAQ + 64 * hd, hi);
    const bf16* k1b = hb + HC_DSAK; const bf16* vb = hb + HC_DSAV;
    const unsigned* bmr = BM + ((size_t)b * SEQ + tq) * 64;
    constexpr int SB_ = fa::Stage<64>::BYTES;
    LAS float* wsf = (LAS float*)(ldsL + 2 * SB_) + wave * 64;
    f32x16 o[2]; o[0] = (f32x16){}; o[1] = (f32x16){}; float m = 0.f, l = 0.f; f32x16 negm = (f32x16){}; bool shifted = false;
    const int ntiles = j + 1;
    fa::Loader<64> ld;
    __syncthreads();
    ld.issue(k1b, nullptr, vb, NH, 0, tid); ld.commit(ldsL, tid);
    unsigned w0n = __hip_atomic_load(bmr, RLX_AGENT), w1n = __hip_atomic_load(bmr + 1, RLX_AGENT);
    __syncthreads();
    for (int it = 0; it < ntiles; ++it) {
        const int key0 = it * 64; LAS unsigned char* st = ldsL + (it & 1) * SB_;
        const unsigned w0 = w0n, w1 = w1n;
        if (it + 1 < ntiles) { ld.issue(k1b, nullptr, vb, NH, key0 + 64, tid); w0n = __hip_atomic_load(bmr + 2 * it + 2, RLX_AGENT); w1n = __hip_atomic_load(bmr + 2 * it + 3, RLX_AGENT); }
        if (__any((w0 | w1) != 0u)) {
            f32x16 p0, p1; if (shifted) fa::qk_tile_pf<64>(p0, p1, st, qr, r32, hi, negm); else fa::qk_tile_pf<64>(p0, p1, st, qr, r32, hi);
#pragma unroll
            for (int r = 0; r < 16; ++r) { const int kb = fa::crow(r, hi); if (!((w0 >> kb) & 1u)) p0[r] = -INFINITY; if (!((w1 >> kb) & 1u)) p1[r] = -INFINITY; }
            fa::softmax_tile3(p0, p1, o, m, l, negm, shifted, wsf, r32, hi);
            fa::pv_tile_pf(o, st + fa::Stage<64>::KB, p0, p1, lane);
        }
        if (it + 1 < ntiles) ld.commit(ldsL + ((it + 1) & 1) * SB_, tid);
        __syncthreads();
    }
    fa::normalize_o(o, l, wsf, r32, hi);
    fa::store_o(o, ycat, (size_t)b * SEQ + q0w, DM, 2 * 256 + hd * 64, r32, hi);
}
__device__ __forceinline__ void nsa_unit(const bf16* H, const bf16* KC, bf16* ycat, int b, int j, LAS unsigned char* ldsL, int tid_in) {
    int tid = tid_in; OPAQUE_V(tid);
    const int lane = tid & 63, wave = __builtin_amdgcn_readfirstlane(tid >> 6), r32 = lane & 31, hi = lane >> 5, qh = wave >> 2, hd = wave & 3;
    const bf16* hb = H + (size_t)b * SEQ * NH;
    constexpr int SB_ = fa::Stage<64>::BYTES;
    LAS float* IMPH = (LAS float*)(ldsL + 32768);
    LAS float* wsf = (LAS float*)(ldsL + 65536) + wave * 64;
    volatile LAS unsigned* SEL = (volatile LAS unsigned*)(ldsL + 65536 + 2048);
    LAS float* GATE = (LAS float*)(ldsL + 65536 + 2048 + 256);
    const int q0w = j * 64 + qh * 32, tq = q0w + r32;
    bf16x8 qr[4]; fa::load_q<64>(qr, hb + (size_t)tq * NH + HC_NSAQ + 64 * hd, hi);
    fa::Loader<64> ld;
    f32x16 oc[2]; oc[0] = (f32x16){}; oc[1] = (f32x16){};
    __syncthreads();
    { const bf16* kcb = KC + (size_t)b * 128 * 64; const bf16* vcb = kcb + (size_t)BATCH * 128 * 64;
      fa::Loader<64> ld2; ld.issue(kcb, nullptr, vcb, 64, 0, tid); ld2.issue(kcb, nullptr, vcb, 64, 64, tid);
      ld.commit(ldsL, tid); ld2.commit(ldsL + SB_, tid);
      for (int e = tid; e < 768; e += NTHR) GATE[e] = bf2f(hb[(size_t)(j * 64 + e / 12) * NH + HC_GATE + e % 12]);
      __syncthreads();
      const int nvis = (tq >= 31) ? (((tq - 31) >> 4) + 1) : 0; const int nv4 = nvis - 4 * hi;
      f32x16 pa0, pa1, pb0, pb1; fa::qk_tile<64>(pa0, pa1, ldsL, qr, r32, hi); fa::qk_tile<64>(pb0, pb1, ldsL + SB_, qr, r32, hi);
      float mx = -INFINITY;
#pragma unroll
      for (int r = 0; r < 16; ++r) { const int c = (r & 3) + 8 * (r >> 2);
          if (c >= nv4) pa0[r] = -INFINITY; if (c + 32 >= nv4) pa1[r] = -INFINITY; if (c + 64 >= nv4) pb0[r] = -INFINITY; if (c + 96 >= nv4) pb1[r] = -INFINITY;
          mx = fmaxf(fmaxf(mx, fmaxf(pa0[r], pa1[r])), fmaxf(pb0[r], pb1[r])); }
      mx = x32_max(mx);
      const float ms = (mx == -INFINITY) ? 0.f : mx; float sm = 0.f;
#pragma unroll
      for (int r = 0; r < 16; ++r) { pa0[r] = ex2(pa0[r] - ms); pa1[r] = ex2(pa1[r] - ms); pb0[r] = ex2(pb0[r] - ms); pb1[r] = ex2(pb1[r] - ms); sm += (pa0[r] + pa1[r]) + (pb0[r] + pb1[r]); }
      sm = x32_sum(sm);
      const float inv = 1.0f / fmaxf(sm, 1e-30f);
#pragma unroll
      for (int r = 0; r < 16; ++r) { pa0[r] *= inv; pa1[r] *= inv; pb0[r] *= inv; pb1[r] *= inv; }
      float GS[16], LE[16];
#pragma unroll
      for (int g = 0; g < 4; ++g) { GS[g] = (pa0[4 * g] + pa0[4 * g + 1]) + (pa0[4 * g + 2] + pa0[4 * g + 3]); LE[g] = pa0[4 * g + 3];
          GS[4 + g] = (pa1[4 * g] + pa1[4 * g + 1]) + (pa1[4 * g + 2] + pa1[4 * g + 3]); LE[4 + g] = pa1[4 * g + 3];
          GS[8 + g] = (pb0[4 * g] + pb0[4 * g + 1]) + (pb0[4 * g + 2] + pb0[4 * g + 3]); LE[8 + g] = pb0[4 * g + 3];
          GS[12 + g] = (pb1[4 * g] + pb1[4 * g + 1]) + (pb1[4 * g + 2] + pb1[4 * g + 3]); LE[12 + g] = pb1[4 * g + 3]; }
      float LEo[16];
#pragma unroll
      for (int k = 0; k < 16; ++k) LEo[k] = x32_other(LE[k], hi);
#pragma unroll
      for (int k = 0; k < 16; ++k) { const float prev = hi ? LEo[k] : (k > 0 ? LEo[k > 0 ? k - 1 : 0] : 0.f);
          IMPH[(hd * 32 + 2 * k + hi) * 64 + qh * 32 + r32] = GS[k] + prev; }
      fa::pv_tile(oc, ldsL + fa::Stage<64>::KB, pa0, pa1, lane);
      fa::pv_tile(oc, ldsL + SB_ + fa::Stage<64>::KB, pb0, pb1, lane);
    }
    fa::Loader<64> lsel; lsel.issue(hb + HC_KSLC, nullptr, hb + HC_VSLC, NH, 0, tid);
    __syncthreads();
    for (int pi = 0; pi < 4; ++pi) { const int ql = wave * 8 + pi * 2 + hi, jj = r32;
        const float imp = ((IMPH[(0 * 32 + jj) * 64 + ql] + IMPH[(1 * 32 + jj) * 64 + ql]) + IMPH[(2 * 32 + jj) * 64 + ql]) + IMPH[(3 * 32 + jj) * 64 + ql];
        float val = (jj == 0 || jj == j || jj == j - 1) ? 1.0e4f : ((jj <= j) ? imp : -1.0e30f);
        unsigned sm = 0u;
        for (int r = 0; r < 8; ++r) { const float mx = half_max(val, hi);
            const unsigned long long bal = __ballot(val == mx); const unsigned mine = hi ? (unsigned)(bal >> 32) : (unsigned)bal; const int first = __builtin_ctz(mine);
            sm |= 1u << first; if (jj == first) val = -3.4e38f; }
        if (r32 == 0) SEL[ql] = sm; }
    __syncthreads();
    unsigned um = SEL[lane];
    um |= (unsigned)sx_i<1>((int)um); um |= (unsigned)sx_i<2>((int)um); um |= (unsigned)sx_i<4>((int)um); um |= (unsigned)sx_i<8>((int)um); um |= (unsigned)sx_i<16>((int)um); um |= x32_other_u(um, hi);
    um = (unsigned)__builtin_amdgcn_readfirstlane((int)um) & ((j >= 31) ? 0xffffffffu : ((2u << j) - 1u));
    const unsigned selq = SEL[qh * 32 + r32];
    f32x16 os[2]; os[0] = (f32x16){}; os[1] = (f32x16){};
    const int jlo = (j >= 8) ? j - 8 : 0;
    fa::Loader<64> lwin; lwin.issue(hb + HC_KWIN, nullptr, hb + HC_VWIN, NH, jlo * 64, tid);
    { const bf16* k1b = hb + HC_KSLC; const bf16* vb = hb + HC_VSLC; float m = -INFINITY, l = 0.f; f32x16 negm = (f32x16){};
      int jb = __builtin_ctz(um); unsigned rest = um & (um - 1u);
      if (jb != 0) lsel.issue(k1b, nullptr, vb, NH, jb * 64, tid);
      lsel.commit(ldsL, tid);
      __syncthreads();
      for (int it = 0;; ++it) {
          const int key0 = jb * 64; LAS unsigned char* st = ldsL + (it & 1) * SB_;
          const bool more = rest != 0u; const int jn = more ? __builtin_ctz(rest) : 0;
          if (more) ld.issue(k1b, nullptr, vb, NH, jn * 64, tid);
          const bool mine = (selq >> jb) & 1u;
          if (__any(mine)) {
              f32x16 p0, p1; fa::qk_tile<64>(p0, p1, st, qr, r32, hi, negm);
              const int rel_ = mine ? (tq - key0 - 4 * hi) : -1;
#pragma unroll
              for (int r = 0; r < 16; ++r) { const int c = (r & 3) + 8 * (r >> 2); if (c > rel_) p0[r] = -INFINITY; if (c + 32 > rel_) p1[r] = -INFINITY; }
              fa::softmax_tile2(p0, p1, os, m, l, negm, wsf, r32, hi);
              fa::pv_tile(os, st + fa::Stage<64>::KB, p0, p1, lane);
          }
          if (more) ld.commit(ldsL + ((it + 1) & 1) * SB_, tid);
          __syncthreads();
          if (!more) break;
          jb = jn; rest &= rest - 1u;
      }
      fa::normalize_o(os, l, wsf, r32, hi); }
    f32x16 ow[2]; ow[0] = (f32x16){}; ow[1] = (f32x16){};
    { const bf16* k1b = hb + HC_KWIN; const bf16* vb = hb + HC_VWIN; float m = -INFINITY, l = 0.f; f32x16 negm = (f32x16){};
      const int ntiles = j - jlo + 1;
      lwin.commit(ldsL, tid);
      __syncthreads();
      for (int it = 0; it < ntiles; ++it) {
          const int key0 = (jlo + it) * 64; LAS unsigned char* st = ldsL + (it & 1) * SB_;
          if (it + 1 < ntiles) ld.issue(k1b, nullptr, vb, NH, key0 + 64, tid);
          { f32x16 p0, p1; fa::qk_tile<64>(p0, p1, st, qr, r32, hi, negm);
            if (key0 + 63 > q0w || key0 < q0w + 31 - 511) {
                const int relw_ = tq - key0 - 4 * hi;
#pragma unroll
                for (int r = 0; r < 16; ++r) { const int c = (r & 3) + 8 * (r >> 2); if (c > relw_ || c < relw_ - 511) p0[r] = -INFINITY; if (c + 32 > relw_ || c + 32 < relw_ - 511) p1[r] = -INFINITY; } }
            fa::softmax_tile2(p0, p1, ow, m, l, negm, wsf, r32, hi);
            fa::pv_tile(ow, st + fa::Stage<64>::KB, p0, p1, lane); }
          if (it + 1 < ntiles) ld.commit(ldsL + ((it + 1) & 1) * SB_, tid);
          __syncthreads();
      }
      fa::normalize_o(ow, l, wsf, r32, hi); }
#pragma unroll
    for (int r = 0; r < 16; ++r) { const int tl = qh * 32 + fa::crow(r, hi); const float g0 = GATE[tl * 12 + hd], g1 = GATE[tl * 12 + 4 + hd], g2 = GATE[tl * 12 + 8 + hd];
        os[0][r] = g0 * oc[0][r] + g1 * os[0][r] + g2 * ow[0][r];
        os[1][r] = g0 * oc[1][r] + g1 * os[1][r] + g2 * ow[1][r]; }
    fa::store_o(os, ycat, (size_t)b * SEQ + q0w, DM, 1 * 256 + hd * 64, r32, hi);
}
__device__ __forceinline__ unsigned wave_sum_u32(unsigned v) {
    int x = (int)v; x += DPP_I(0, x, 0x111, 0xf); x += DPP_I(0, x, 0x112, 0xf); x += DPP_I(0, x, 0x114, 0xf); x += DPP_I(0, x, 0x118, 0xf); x += DPP_I(0, x, 0x142, 0xa); x += DPP_I(0, x, 0x143, 0xc);
    return (unsigned)__builtin_amdgcn_readlane(x, 63);
}
__device__ __forceinline__ void topk_emit(const float (&v)[32], int t, bool all, float thr, bool tie, int need, unsigned* bm, int lane) {
    if (all) {
#pragma unroll
        for (int i = 0; i < 32; ++i) { const unsigned long long mask = __ballot(64 * i + lane <= t); if (lane < 2) bm[2 * i + lane] = (unsigned)(mask >> (32 * lane)); }
    } else if (!tie) {
#pragma unroll
        for (int i = 0; i < 32; ++i) { const unsigned long long mask = __ballot(v[i] >= thr); if (lane < 2) bm[2 * i + lane] = (unsigned)(mask >> (32 * lane)); }
    } else {
#pragma unroll
        for (int i = 0; i < 32; ++i) { const unsigned long long gt = __ballot(v[i] > thr), eq = __ballot(v[i] == thr); unsigned long long take = eq;
            const int ce = __builtin_popcountll(eq); if (ce <= need) need -= ce; else { unsigned long long mm = eq; take = 0ull; for (int q = 0; q < need; ++q) { const unsigned long long bb = mm & (~mm + 1ull); take |= bb; mm ^= bb; } need = 0; }
            const unsigned long long mask = gt | take; if (lane < 2) bm[2 * i + lane] = (unsigned)(mask >> (32 * lane)); }
    }
}
template <bool EMIT = true, int CAP = 1000> __device__ __forceinline__ void topk_rows2(const float (&v0)[32], const float (&v1)[32], int t0, int t1, unsigned* bm0, unsigned* bm1, int lane, LAS unsigned* HW, LAS float* CW) {
    const bool all0 = (t0 < 256), all1 = (t1 < 256);
    float lo0, hi0, lo1, hi1, thr0 = -3.0e38f, thr1 = -3.0e38f; bool tie0 = false, tie1 = false, done0 = all0, done1 = all1; int need0 = -1, need1 = -1;
    { float mx0 = -3.0e38f, mn0 = 3.0e38f, mx1 = -3.0e38f, mn1 = 3.0e38f;
#pragma unroll
      for (int i = 0; i < 32; ++i) { mx0 = __builtin_amdgcn_fmed3f(mx0, v0[i], __builtin_inff()); mn0 = __builtin_amdgcn_fmed3f(mn0, (v0[i] > -1.0e38f) ? v0[i] : 3.0e38f, -__builtin_inff());
                                     mx1 = __builtin_amdgcn_fmed3f(mx1, v1[i], __builtin_inff()); mn1 = __builtin_amdgcn_fmed3f(mn1, (v1[i] > -1.0e38f) ? v1[i] : 3.0e38f, -__builtin_inff()); }
      hi0 = wave_max(mx0); lo0 = wave_min(mn0); hi1 = wave_max(mx1); lo1 = wave_min(mn1); }
    {
        const bool a0 = !done0 && (hi0 > lo0), a1 = !done1 && (hi1 > lo1);
        if (a0 || a1) {
            const int ni = __builtin_amdgcn_readfirstlane((t1 >> 6) + 1);
            const float s0 = fminf(254.5f / (hi0 - lo0), 3.0e38f), s1 = fminf(254.5f / (hi1 - lo1), 3.0e38f);
            const float c0 = a0 ? lo0 : 3.0e38f, c1 = a1 ? lo1 : 3.0e38f;
            { unsigned z_ = 0u; OPAQUE_V(z_); *(LAS v4u*)(HW + 4 * lane) = (v4u){z_, z_, z_, z_}; }
            __builtin_amdgcn_fence(__ATOMIC_RELEASE, "wavefront");
#define BIN0(x) (((x) >= c0) ? min((int)(((x) - lo0) * s0), 254) : 255)
#define BIN1(x) (((x) >= c1) ? min((int)(((x) - lo1) * s1), 254) : 255)
            unsigned pk0[8], pk1[8];
#pragma unroll
            for (int g = 0; g < 32; ++g) if (g < ni) {
#pragma unroll
                for (int j = 0; j < 1; ++j) { const int i = g; const unsigned b0 = (unsigned)BIN0(v0[i]), b1 = (unsigned)BIN1(v1[i]);
                    __hip_atomic_fetch_add(HW + b0, 1u, __ATOMIC_RELAXED, __HIP_MEMORY_SCOPE_WAVEFRONT);
                    __hip_atomic_fetch_add(HW + b1, 0x10000u, __ATOMIC_RELAXED, __HIP_MEMORY_SCOPE_WAVEFRONT);
                    if ((i & 3) == 0) { pk0[i >> 2] = b0; pk1[i >> 2] = b1; } else { pk0[i >> 2] |= b0 << (8 * (i & 3)); pk1[i >> 2] |= b1 << (8 * (i & 3)); } } }
            __builtin_amdgcn_fence(__ATOMIC_ACQ_REL, "wavefront");
            v4u hq = *(LAS v4u*)(HW + 4 * lane);
            if (lane == 63) hq.w = 0u;
            const unsigned sl = hq.x + hq.y + hq.z + hq.w;
            int ps = (int)sl; ps += DPP_I(0, ps, 0x111, 0xf); ps += DPP_I(0, ps, 0x112, 0xf); ps += DPP_I(0, ps, 0x114, 0xf); ps += DPP_I(0, ps, 0x118, 0xf); ps += DPP_I(0, ps, 0x142, 0xa); ps += DPP_I(0, ps, 0x143, 0xc);
            const unsigned above = (unsigned)__builtin_amdgcn_readlane(ps, 63) - (unsigned)ps;
            int B0 = -1, B1 = -1, k0 = 0, k1 = 0, n0 = 0, n1 = 0;
#define PICK(sh, act, Bx, kx, nx) do { const int ab_ = (int)((above >> (sh)) & 0xffffu), cl_ = (int)((sl >> (sh)) & 0xffffu); \
                const unsigned long long hm_ = __ballot((act) && ab_ < 256 && ab_ + cl_ >= 256); \
                if (hm_ != 0ull) { const int L_ = __builtin_ctzll(hm_); int a_ = ab_, bs_ = 0, ca_ = 0, bc_ = 0; \
                    { const int q_ = (int)((hq.w >> (sh)) & 0xffffu); if (a_ < 256 && a_ + q_ >= 256) { bs_ = 4 * lane + 3; ca_ = a_; bc_ = q_; } a_ += q_; } \
                    { const int q_ = (int)((hq.z >> (sh)) & 0xffffu); if (a_ < 256 && a_ + q_ >= 256) { bs_ = 4 * lane + 2; ca_ = a_; bc_ = q_; } a_ += q_; } \
                    { const int q_ = (int)((hq.y >> (sh)) & 0xffffu); if (a_ < 256 && a_ + q_ >= 256) { bs_ = 4 * lane + 1; ca_ = a_; bc_ = q_; } a_ += q_; } \
                    { const int q_ = (int)((hq.x >> (sh)) & 0xffffu); if (a_ < 256 && a_ + q_ >= 256) { bs_ = 4 * lane + 0; ca_ = a_; bc_ = q_; } a_ += q_; } \
                    Bx = __builtin_amdgcn_readlane(bs_, L_); kx = 256 - __builtin_amdgcn_readlane(ca_, L_); nx = __builtin_amdgcn_readlane(bc_, L_); } } while (0)
            PICK(0, a0, B0, k0, n0); PICK(16, a1, B1, k1, n1);
#undef PICK
            const bool r0 = (B0 >= 0) && n0 <= 64, r1 = (B1 >= 0) && n1 <= 64;
            if (r0 || r1) {
                const unsigned bb0 = r0 ? (unsigned)B0 : 0x1000u, bb1 = r1 ? (unsigned)B1 : 0x1000u;
                int base0 = 0, base1 = 0;
#pragma unroll
                for (int g = 0; g < 32; ++g) if (g < ni) {
#pragma unroll
                    for (int j = 0; j < 1; ++j) { const int i = g;
                        const bool m0 = ((pk0[i >> 2] >> (8 * (i & 3))) & 0xffu) == bb0, m1 = ((pk1[i >> 2] >> (8 * (i & 3))) & 0xffu) == bb1;
                        const unsigned long long q0 = __ballot(m0), q1 = __ballot(m1);
                        if ((q0 | q1) != 0ull) {
                            if (m0) CW[base0 + (int)__builtin_amdgcn_mbcnt_hi((unsigned)(q0 >> 32), __builtin_amdgcn_mbcnt_lo((unsigned)q0, 0u))] = v0[i];
                            if (m1) CW[64 + base1 + (int)__builtin_amdgcn_mbcnt_hi((unsigned)(q1 >> 32), __builtin_amdgcn_mbcnt_lo((unsigned)q1, 0u))] = v1[i];
                            base0 += __builtin_popcountll(q0); base1 += __builtin_popcountll(q1); } } }
                __builtin_amdgcn_fence(__ATOMIC_ACQ_REL, "wavefront");
#define RANK(rx, nx, kx, off, thrx, tiex, needx, donex) do { if (rx) { const float c_ = (lane < (nx)) ? CW[(off) + lane] : -3.0e38f; int gt_ = 0, ge_ = 0; \
                    for (int m_ = 0; m_ < (nx); ++m_) { const float cm_ = __int_as_float(__builtin_amdgcn_readlane(__float_as_int(c_), m_)); gt_ += (cm_ > c_) ? 1 : 0; ge_ += (cm_ >= c_) ? 1 : 0; } \
                    const unsigned long long hm_ = __ballot(lane < (nx) && gt_ < (kx) && (kx) <= ge_); \
                    if (hm_ != 0ull) { const int L_ = __builtin_ctzll(hm_); thrx = __int_as_float(__builtin_amdgcn_readlane(__float_as_int(c_), L_)); \
                        const int G_ = __builtin_amdgcn_readlane(gt_, L_), E_ = __builtin_amdgcn_readlane(ge_, L_); tiex = (E_ > (kx)); needx = (kx) - G_; donex = true; } } } while (0)
                RANK(r0, n0, k0, 0, thr0, tie0, need0, done0); RANK(r1, n1, k1, 64, thr1, tie1, need1, done1);
#undef RANK
            }
#undef BIN0
#undef BIN1
        }
    }
#define CNT2(x0, x1, c0, c1) do { unsigned c_ = 0u; int sa_ = 0, sb_ = 0; _Pragma("unroll") for (int i_ = 0; i_ < 32; ++i_) { \
            if (i_ & 1) { sa_ += __builtin_popcountll(__ballot(v0[i_] >= (x0))); sb_ += __builtin_popcountll(__ballot(v1[i_] >= (x1))); }     \
            else { c_ += (v0[i_] >= (x0)) ? 1u : 0u; c_ += (v1[i_] >= (x1)) ? 0x10000u : 0u; } }                                                 \
        c_ = wave_sum_u32(c_); c0 = (int)(c_ & 0xffffu) + sa_; c1 = (int)(c_ >> 16) + sb_; } while (0)
    if (!(done0 && done1)) {
        int c0, c1; CNT2(hi0, hi1, c0, c1);
        if (!done0 && c0 >= 256) { thr0 = hi0; tie0 = (c0 > 256); done0 = true; }
        if (!done1 && c1 >= 256) { thr1 = hi1; tie1 = (c1 > 256); done1 = true; }
        for (int it = 0; it < 14 && !(done0 && done1); ++it) {
            const float mid0 = 0.5f * (lo0 + hi0), mid1 = 0.5f * (lo1 + hi1);
            if (!done0 && !(mid0 > lo0 && mid0 < hi0)) { thr0 = lo0; tie0 = true; done0 = true; }
            if (!done1 && !(mid1 > lo1 && mid1 < hi1)) { thr1 = lo1; tie1 = true; done1 = true; }
            if (done0 && done1) break;
            CNT2(mid0, mid1, c0, c1);
            if (!done0) { if (c0 == 256) { thr0 = mid0; done0 = true; } else if (c0 > 256) lo0 = mid0; else hi0 = mid0; }
            if (!done1) { if (c1 == 256) { thr1 = mid1; done1 = true; } else if (c1 > 256) lo1 = mid1; else hi1 = mid1; }
        }
        if (!(done0 && done1)) {
#define F2KEY(f) ({ const unsigned u_ = __float_as_uint(f); (u_ & 0x80000000u) ? ~u_ : (u_ | 0x80000000u); })
#define KEY2F(k) ({ const unsigned k_ = (k); __uint_as_float((k_ & 0x80000000u) ? (k_ & 0x7fffffffu) : ~k_); })
            unsigned kl0 = F2KEY(lo0), kh0 = F2KEY(hi0), kl1 = F2KEY(lo1), kh1 = F2KEY(hi1);
            while (!(done0 && done1)) {
                if (!done0 && kh0 - kl0 <= 1u) { thr0 = KEY2F(kl0); tie0 = true; done0 = true; }
                if (!done1 && kh1 - kl1 <= 1u) { thr1 = KEY2F(kl1); tie1 = true; done1 = true; }
                if (done0 && done1) break;
                const unsigned km0 = kl0 + ((kh0 - kl0) >> 1), km1 = kl1 + ((kh1 - kl1) >> 1);
                const float mid0 = KEY2F(km0), mid1 = KEY2F(km1);
                CNT2(mid0, mid1, c0, c1);
                if (!done0) { if (c0 == 256) { thr0 = mid0; done0 = true; } else if (c0 > 256) kl0 = km0; else kh0 = km0; }
                if (!done1) { if (c1 == 256) { thr1 = mid1; done1 = true; } else if (c1 > 256) kl1 = km1; else kh1 = km1; }
            }
#undef F2KEY
#undef KEY2F
        }
        if ((tie0 && need0 < 0) || (tie1 && need1 < 0)) { unsigned c_ = 0u;
#pragma unroll
            for (int i = 0; i < 32; ++i) { c_ += (v0[i] > thr0) ? 1u : 0u; c_ += (v1[i] > thr1) ? 0x10000u : 0u; }
            c_ = wave_sum_u32(c_); if (need0 < 0) need0 = 256 - (int)(c_ & 0xffffu); if (need1 < 0) need1 = 256 - (int)(c_ >> 16); }
    }
#undef CNT2
    if constexpr (EMIT) { topk_emit(v0, t0, all0, thr0, tie0, need0, bm0, lane);
    topk_emit(v1, t1, all1, thr1, tie1, need1, bm1, lane); } else { if (thr0 + thr1 == 12345.678f && lane == 0) bm0[0] = 0u; }
}
#define RELU1(x) __int_as_float(max(__float_as_int(x), 0))
template <int MODE = 0> __device__ __forceinline__ void idx_unit(const bf16* H, unsigned* BM, int b, int q16, LAS unsigned char* ldsL, int tid_in) {
    int tid = tid_in; OPAQUE_V(tid);
    const int lane = tid & 63, wave = __builtin_amdgcn_readfirstlane(tid >> 6), qc = lane & 15, kg = lane >> 4;
    const bf16* hb = H + (size_t)b * SEQ * NH;
    const int t0 = q16 * 16, tq = t0 + qc, nkt = q16 + 1;
    LAS float* SC = (LAS float*)ldsL;
    bf16x8 qf[8]; float wq[8];
#pragma unroll
    for (int hh = 0; hh < 8; ++hh) { qf[hh] = *(const bf16x8*)(hb + (size_t)tq * NH + HC_IDXQ + hh * 32 + kg * 8); wq[hh] = bf2f(hb[(size_t)tq * NH + HC_IDXW + hh]); }
    __syncthreads();
    bf16x8 kfs[16];
#pragma unroll
    for (int i = 0; i < 16; ++i) { const int kt = wave + 8 * i; if (kt < nkt) kfs[i] = *(const bf16x8*)(hb + (size_t)(kt * 16 + qc) * NH + HC_IDXK + kg * 8); }
#pragma unroll
    for (int i = 0; i < 16; ++i) { const int kt = wave + 8 * i;
        if (kt < nkt) {
        const int key0 = kt * 16;
        f32x4 sc = (f32x4){0.f, 0.f, 0.f, 0.f};
#pragma unroll
        for (int hh = 0; hh < 8; ++hh) { const f32x4 d = __builtin_amdgcn_mfma_f32_16x16x32_bf16(kfs[i], qf[hh], (f32x4){0.f, 0.f, 0.f, 0.f}, 0, 0, 0);
            sc[0] += wq[hh] * RELU1(d[0]); sc[1] += wq[hh] * RELU1(d[1]); sc[2] += wq[hh] * RELU1(d[2]); sc[3] += wq[hh] * RELU1(d[3]); }
        if (kt == nkt - 1) {
#pragma unroll
            for (int r = 0; r < 4; ++r) if (key0 + 4 * kg + r > tq) sc[r] = -3.0e38f; }
        *(LAS f32x4*)(SC + qc * 2048 + key0 + 4 * kg) = sc;
        } }
    __syncthreads();
    const int nk = nkt * 16;
    if constexpr (MODE == 0 || MODE == 2 || MODE == 3) { const int row = wave * 2; float v0[32], v1[32];
#pragma unroll
      for (int i = 0; i < 32; ++i) { const bool ok = (64 * i + lane < nk); v0[i] = ok ? SC[row * 2048 + 64 * i + lane] : -3.0e38f; v1[i] = ok ? SC[(row + 1) * 2048 + 64 * i + lane] : -3.0e38f; }
      topk_rows2<MODE == 0, (MODE == 3 ? 32 : 1000)>(v0, v1, t0 + row, t0 + row + 1, BM + ((size_t)b * SEQ + t0 + row) * 64, BM + ((size_t)b * SEQ + t0 + row + 1) * 64, lane, (LAS unsigned*)(ldsL + RING_BYTES + 1024) + wave * 256, (LAS float*)(ldsL + RING_BYTES + 1024 + 8192) + wave * 128); }
}
__device__ __forceinline__ void compress_unit(PP p, int l, int item, LAS unsigned char* ldsL, int tid_in) {
    int tid = tid_in; OPAQUE_V(tid);
    const int lane = tid & 63, wave = __builtin_amdgcn_readfirstlane(tid >> 6), rr = lane & 15, kq = lane >> 4;
    const int kv = item >> 7, b = (item >> 3) & 15, n0 = (item & 7) * 16;
    const bf16* hb = (const bf16*)(p->ws + WS_BIG) + (size_t)b * SEQ * NH + (kv ? HC_VCMP : HC_KCMP);
    const bf16* w1t = (const bf16*)(p->ws + WS_CW1) + (size_t)(l * 2 + kv) * 64 * 2048;
    const int row = tid >> 5, c0 = 2 * (tid & 31);
    float cbv[2][32];
    { const float* cb = (const float*)(p->ws + WS_CBIAS) + (l * 2 + kv) * 32 * 64;
#pragma unroll
      for (int e = 0; e < 2; ++e)
#pragma unroll
          for (int pp = 0; pp < 32; ++pp) cbv[e][pp] = cb[pp * 64 + c0 + e]; }
    const f32x4* w2g = (const f32x4*)(p->in[kv ? I_WV2 : I_WK2] + (size_t)l * 64 * 64) + 2 * tid;
    const f32x4 w2a = w2g[0], w2b = w2g[1];
    __builtin_amdgcn_sched_barrier(0);
    f32x4 acc[4];
#pragma unroll
    for (int nt = 0; nt < 4; ++nt) acc[nt] = (f32x4){0.f, 0.f, 0.f, 0.f};
#pragma unroll
    for (int half = 0; half < 2; ++half) {
        bf16x8 af[4], bfr[4][4];
#pragma unroll
        for (int k4 = 0; k4 < 4; ++k4) { const int ks = half * 4 + k4; int tok = 16 * (n0 + rr) + 4 * wave + (ks >> 1); tok = tok > SEQ - 1 ? SEQ - 1 : tok;
            af[k4] = *(const bf16x8*)(hb + (size_t)tok * NH + 32 * (ks & 1) + 8 * kq);
#pragma unroll
            for (int nt = 0; nt < 4; ++nt) bfr[k4][nt] = *(const bf16x8*)(w1t + (size_t)(16 * nt + rr) * 2048 + 256 * wave + 32 * ks + 8 * kq); }
#pragma unroll
        for (int k4 = 0; k4 < 4; ++k4)
#pragma unroll
            for (int nt = 0; nt < 4; ++nt) acc[nt] = __builtin_amdgcn_mfma_f32_16x16x32_bf16(af[k4], bfr[k4][nt], acc[nt], 0, 0, 0);
    }
    LAS float* PS = (LAS float*)ldsL;
    LAS float* HD = (LAS float*)(ldsL + 32768);
    LAS float* W2L = (LAS float*)(ldsL + 36864);
    __syncthreads();
#pragma unroll
    for (int nt = 0; nt < 4; ++nt)
#pragma unroll
        for (int r = 0; r < 4; ++r) PS[(wave * 16 + 4 * kq + r) * 64 + 16 * nt + rr] = acc[nt][r];
    *(LAS f32x4*)(W2L + 8 * tid) = w2a; *(LAS f32x4*)(W2L + 8 * tid + 4) = w2b;
    __syncthreads();
    {
#pragma unroll
      for (int e = 0; e < 2; ++e) { float a = 0.f;
#pragma unroll
          for (int pp = 0; pp < 32; ++pp) a += cbv[e][pp];
#pragma unroll
          for (int w = 0; w < 8; ++w) a += PS[(w * 16 + row) * 64 + c0 + e];
          const float u = 0.7978845608028654f * (a + 0.044715f * a * a * a), th = 1.0f - 2.0f / (__expf(2.0f * u) + 1.0f);
          HD[row * 64 + c0 + e] = 0.5f * a * (1.0f + th); } }
    __syncthreads();
    { float o0 = 0.f, o1 = 0.f;
#pragma unroll 8
      for (int jj = 0; jj < 64; ++jj) { const float hv = HD[row * 64 + jj]; const f32x2 wv = *(const LAS f32x2*)(W2L + jj * 64 + c0); o0 += hv * wv.x; o1 += hv * wv.y; }
      const int n = n0 + row; if (n == 127) { o0 = 0.f; o1 = 0.f; }
      *(unsigned*)((bf16*)(p->ws + WS_KC) + ((size_t)(kv * BATCH + b) * 128 + n) * 64 + c0) = pk2(o0, o1); }
}
__global__ void __launch_bounds__(NTHR, 2) fwd(P p_arg_unused) {
    extern __shared__ __attribute__((aligned(16))) unsigned char lds[];
    LAS unsigned char* ldsL = (LAS unsigned char*)lds;
    const int wave = __builtin_amdgcn_readfirstlane((int)threadIdx.x >> 6);
#define TIDNOW() (wave * 64 + lane_id())
    const int G = gridDim.x, bx = blockIdx.x, vcu = (G % 8 == 0) ? (bx % 8) * (G / 8) + bx / 8 : bx;
    const int gw0 = vcu * NWAVES + wave, NGW = G * NWAVES;
#define FRESH() int lane = lane_id(), gw = gw0; OPAQUE_V(lane); OPAQUE_S(gw); const int tidf = wave * 64 + lane
    for (int u = TIDNOW(); u < (LDS_BYTES - RING_BYTES) / 4; u += NTHR) ((LAS unsigned*)(ldsL + RING_BYTES))[u] = 0u;
    __syncthreads();
#define WSP (getp()->ws)
    XcdBarrier bar = xcd_barrier_post((unsigned*)(getp()->ws + WS_CTL) + CW_BAR, (volatile LAS unsigned*)(ldsL + MISC_OFF) + 8);
#define GRID_BAR() do { XcdBarrier b_ = bar; unsigned x_ = b_.x; unsigned* p_ = b_.bar; asm volatile("" : "+s"(x_), "+s"(p_)); b_.x = x_; b_.bar = p_; xcd_barrier_w(b_, TIDNOW() == 0); } while (0)
    LAS float* wscr = (LAS float*)(ldsL + wave * 16384);
#define XB ((bf16*)(WSP + WS_XB))
#define HB ((bf16*)(WSP + WS_BIG))
#define YC ((bf16*)(WSP + WS_YCAT))
#define OUTP (getp()->out)

    for (int rep = 0; rep < 1 + PROBE_PRO; ++rep) { FRESH(); prologue(getp(), ldsL, gw, NGW, lane, wave); }
    GRID_BAR();

#define GEMM_PHASE(EPI, A_, B_, N_, K_, ...) do { pg8::Gemm g_{(const pg8::bf16_t*)(A_), (const pg8::bf16_t*)(B_), M, (N_), (K_)}; pg8::StaticOrder S_; S_.init(M, (N_), G, bx); \
        pg8::EPI E_{__VA_ARGS__}; pg8::gemm_phase<pg8::EPI, pg8::StaticOrder, true, true>(ldsL, g_, S_, E_, TIDNOW()); } while (0)

#define GEMM_PHASE8(EPI, A_, B_, N_, K_, ...) do { pg8::Gemm g_{(const pg8::bf16_t*)(A_), (const pg8::bf16_t*)(B_), M, (N_), (K_)}; pg8::StaticOrder S_; S_.init(M, (N_), G, bx); \
        pg8::EPI E_{__VA_ARGS__}; pg8::gemm_phase<pg8::EPI, pg8::StaticOrder, true, true, true>(ldsL, g_, S_, E_, TIDNOW()); } while (0)
#define XQ8 (WSP + WS_XQ8)
#define H8 (WSP + WS_BIG)
    for (int l = 0; l < DEPTH; ++l) {
        unsigned char* wl = WSP + WS_W + (size_t)l * W_LAYER;
        for (int rep = 0; rep < 1 + PROBE_UP; ++rep) { GEMM_PHASE8(EpiSwiGLU8, XQ8, wl + WO_13A, 2 * FF, DM / 2, H8, FF, 1.0f / W13_SCALE); }
        GRID_BAR();
        GEMM_PHASE8(EpiResid, H8, wl + WO_2A, DM, FF / 2, XB, DM, DN_ALPHA, 0.5f / W2_SCALE);
        GRID_BAR();
        { FRESH(); ln_phase(XB, nullptr, getp()->in[I_LN1G] + l * DM, getp()->in[I_LN1B] + l * DM, gw, NGW, lane); }
        for (int rep = 0; rep < PROBE_BAR; ++rep) GRID_BAR();
        GRID_BAR();
        for (int rep = 0; rep < PROBE_PREP; ++rep) { GEMM_PHASE(EpiBf16, XB, wl + WO_IN, NH, DM, HB, NH); GRID_BAR(); { FRESH(); const f32x2* T64 = (const f32x2*)(WSP + WS_TAB); const f32x2* T32 = (const f32x2*)(WSP + WS_T32); for (int m = gw; m < M; m += NGW) prep_token(HB + (size_t)m * NH, m % SEQ, T64, T32, lane); } GRID_BAR(); }
        GEMM_PHASE(EpiBf16, XB, wl + WO_IN, NH, DM, HB, NH);
        GRID_BAR();
        { FRESH(); const f32x2* T64 = (const f32x2*)(WSP + WS_TAB); const f32x2* T32 = (const f32x2*)(WSP + WS_T32);
          for (int m = gw; m < M; m += 2 * NGW) { u32x4 ra[6], rb[6]; const int m2 = (m + NGW < M) ? m + NGW : m;
              prep_load(HB + (size_t)m * NH, ra, lane); prep_load(HB + (size_t)m2 * NH, rb, lane);
              PrepTab ta, tb; prep_tab_load(ta, m % SEQ, T64, T32, lane); prep_tab_load(tb, m2 % SEQ, T64, T32, lane);
              prep_row(HB + (size_t)m * NH, ra, m % SEQ, ta, lane);
              if (m2 != m) prep_row(HB + (size_t)m2 * NH, rb, m2 % SEQ, tb, lane); }
        }
        GRID_BAR();
        for (int rep = 0; rep < 1 + PROBE_CMP; ++rep) { FRESH(); for (int it = vcu; it < 2 * BATCH * 8; it += G) compress_unit(getp(), l, it, ldsL, tidf); }
        GRID_BAR();
        for (int repa = 0; repa < 1 + PROBE_ATT + (PROBE_SOLO >= 0 ? 1 : 0); ++repa) {
        { FRESH(); unsigned* qctr = (unsigned*)(WSP + WS_CTL) + CW_QUEUE + l * 128 + repa * 16; volatile LAS int* slot = (volatile LAS int*)(ldsL + MISC_OFF + 64);
          if (__builtin_amdgcn_readfirstlane(tidf >> 6) >= 4) __builtin_amdgcn_s_setprio(1);
          for (;;) {
              __syncthreads();
              if (tidf == 0) *slot = (int)atomicAdd(qctr, 1u);
              __syncthreads();
              const int item = __builtin_amdgcn_readfirstlane(*slot);
              if (item >= ((PROBE_SOLO >= 0 && repa == 1) ? 512 : 2048 + (PROBE_KIND >= 0 ? 512 * PROBE_MULT : 0))) break;
              const int kind = (PROBE_SOLO >= 0 && repa == 1) ? PROBE_SOLO : ((item < 2048) ? ((0x2031 >> (4 * (item >> 9))) & 3) : PROBE_KIND), c = item & 511, jd = 31 - (c >> 4), bd = c & 15;
              if (kind == 0) { const int qb = 7 - c / 64, bh = c % 64; mla_unit(HB, YC, bh >> 2, bh & 3, qb, ldsL, tidf); }
              else if (kind == 1) {
#if FAST_NSA
                  nsa_unit(HB, (const bf16*)(WSP + WS_KC), YC, bd, jd, ldsL, tidf);
#else
                  for (int k = 0; k < 8; ++k) attn_token_naive<4>(getp(), bd * SEQ + jd * 64 + wave * 8 + k, wscr, lane);
#endif
              } else if (kind == 2) {
#if FAST_SB
                  const int qb = 7 - c / 64, bh = c % 64; sb_unit(HB, YC, bh >> 2, bh & 3, qb, ldsL, tidf);
#else
                  for (int k = 0; k < 8; ++k) attn_token_naive<2>(getp(), bd * SEQ + jd * 64 + wave * 8 + k, wscr, lane);
#endif
              } else {
#if FAST_DSA
                  if (PROBE_SOLO == 3 && repa == 1) { for (int k = 3; k >= 0; --k) idx_unit<PROBE_IDXMODE>(HB, (unsigned*)(WSP + WS_BITM), bd, jd * 4 + k, ldsL, tidf); } else
                  { for (int k = 3; k >= 0; --k) idx_unit(HB, (unsigned*)(WSP + WS_BITM), bd, jd * 4 + k, ldsL, tidf);
                    asm volatile("s_waitcnt vmcnt(0)" ::: "memory"); __syncthreads();
                    dsa_unit(HB, (const unsigned*)(WSP + WS_BITM), YC, bd, jd, ldsL, tidf); }
#else
                  for (int k = 0; k < 8; ++k) attn_token_naive<8>(getp(), bd * SEQ + jd * 64 + wave * 8 + k, wscr, lane);
#endif
              }
          }
          __builtin_amdgcn_s_setprio(0); }
        GRID_BAR();
        }
        { FRESH(); gnorm_phase(YC, XQ8, gw, NGW, lane); }
        GRID_BAR();
        GEMM_PHASE8(EpiResid, XQ8, wl + WO_OUT, DM, DM / 2, XB, DM, DN_ALPHA, 1.0f / WOUT_SCALE);
        GRID_BAR();
        { FRESH(); ln_phase(XB, nullptr, getp()->in[I_LN2G] + l * DM, getp()->in[I_LN2B] + l * DM, gw, NGW, lane, XQ8); }
        GRID_BAR();
        GEMM_PHASE8(EpiSwiGLU8, XQ8, wl + WO_13B, 2 * FF, DM / 2, H8, FF, 1.0f / W13_SCALE);
        GRID_BAR();
        GEMM_PHASE8(EpiResid, H8, wl + WO_2B, DM, FF / 2, XB, DM, DN_ALPHA, 0.5f / W2_SCALE);
        GRID_BAR();
        { FRESH(); ln_phase(XB, (l == DEPTH - 1) ? OUTP : nullptr, getp()->in[I_LN3G] + l * DM, getp()->in[I_LN3B] + l * DM, gw, NGW, lane, XQ8); }
        if (l + 1 < DEPTH) GRID_BAR();
    }
#undef GEMM_PHASE
#undef GEMM_PHASE8
#undef XQ8
#undef H8
#undef TIDNOW
#undef WSP
#undef XB
#undef HB
#undef YC
#undef OUTP
}

extern "C" void kernel_launch(void* const* d_in, const int* in_sizes, int n_in, void* d_out, int out_size, void* d_ws, size_t ws_size, hipStream_t stream) {
    static int grid = 0;
    if (grid == 0) {
        if (n_in != N_IN || in_sizes[0] != M * DM || out_size != M * DM || ws_size < WS_END) { fprintf(stderr, "kernel_launch: unexpected shapes (n_in %d, in0 %d, out %d, ws %zu < %zu); nothing launched\n", n_in, n_in > 0 ? in_sizes[0] : -1, out_size, ws_size, (size_t)WS_END); grid = -1; return; }
        int dev = 0, cus = 0, per_cu = 0;
        if (hipGetDevice(&dev) != hipSuccess || hipDeviceGetAttribute(&cus, hipDeviceAttributeMultiprocessorCount, dev) != hipSuccess) { grid = -1; return; }
        if (hipFuncSetAttribute((const void*)fwd, hipFuncAttributeMaxDynamicSharedMemorySize, LDS_BYTES) != hipSuccess) { fprintf(stderr, "kernel_launch: hipFuncSetAttribute failed\n"); grid = -1; return; }
        if (hipOccupancyMaxActiveBlocksPerMultiprocessor(&per_cu, (const void*)fwd, NTHR, LDS_BYTES) != hipSuccess || per_cu < 1) fprintf(stderr, "kernel_launch: note: occupancy query reports %d\n", per_cu);
        (void)hipGetLastError();
        grid = cus;
    }
    if (grid < 0) return;
    if (hipMemsetAsync((char*)d_ws + WS_CTL, 0, CTL_ZERO_BYTES, stream) != hipSuccess) return;
    P p{};
    for (int i = 0; i < N_IN; ++i) p.in[i] = (const float*)d_in[i];
    p.out = (float*)d_out; p.ws = (unsigned char*)d_ws;
    hipLaunchKernelGGL(fwd, dim3(grid), dim3(NTHR), LDS_BYTES, stream, p);
}
```
